# Optimizing an MI355X kernel written in HIP

```python
import math
import jax, jax.numpy as jnp
from jax import lax
import numpy as np

D_MODEL = 1024
BATCH = 2
SEQ = 8192
DEPTH = 1

CONV_DIM = D_MODEL
CONV_WIDTH = 3
HEAD_DIM = 64
ATTN_SLOTS = 8
WINDOWS = (128, 512, 2048)
DILATIONS = (1, 4, 16)
N_GROUPS = len(WINDOWS)
ATTN_HEADS = N_GROUPS * ATTN_SLOTS
ATTN_DIM = ATTN_HEADS * HEAD_DIM
ATTN_OUT = ATTN_SLOTS * HEAD_DIM
Q_BLOCK = 128
EPS = 1e-6
NEG_INF = -1e30

IN_SIZES = (CONV_DIM, CONV_DIM, CONV_DIM, CONV_DIM,
            ATTN_DIM, ATTN_DIM, ATTN_DIM,
            ATTN_OUT,
            D_MODEL, D_MODEL)
IN_TOTAL = sum(IN_SIZES)
IN_SPLITS = tuple(int(v) for v in np.cumsum(IN_SIZES)[:-1])

kernel_name = "hybrid_shortconv_dilated_swa_gated_merge"


def rms_norm(t, w):
    tf = t.astype(jnp.float32)
    tf = tf * lax.rsqrt(jnp.mean(tf * tf, axis=-1, keepdims=True) + EPS)
    return (tf * w.astype(jnp.float32)).astype(t.dtype)


def window_attend(q, k, v, w_sub):
    n, length, hd = q.shape
    blk = math.gcd(Q_BLOCK, length)
    nblk = length // blk
    span = blk + w_sub
    kp = jnp.pad(k, ((0, 0), (w_sub, 0), (0, 0)))
    vp = jnp.pad(v, ((0, 0), (w_sub, 0), (0, 0)))
    idx = jnp.arange(nblk)[:, None] * blk + jnp.arange(span)[None, :]
    kb = kp[:, idx]
    vb = vp[:, idx]
    qb = q.reshape(n, nblk, blk, hd)
    scores = jnp.einsum('nbqd,nbkd->nbqk', qb, kb, preferred_element_type=jnp.float32) * (hd ** -0.5)
    dist = jnp.arange(blk)[:, None] + w_sub - jnp.arange(span)[None, :]
    valid = (dist >= 0) & (dist <= w_sub)
    valid = valid[None, :, :] & (idx >= w_sub)[:, None, :]
    scores = jnp.where(valid, scores, NEG_INF)
    mx = jnp.max(scores, axis=-1)
    p = jnp.exp(scores - mx[..., None])
    s = jnp.sum(p, axis=-1)
    o = jnp.einsum('nbqk,nbkd->nbqd', p, vb.astype(jnp.float32))
    return o.reshape(n, length, hd), mx.reshape(n, length), s.reshape(n, length)


def dilated_attend(q, k, v, window, dilation):
    b, s_len, h, hd = q.shape
    length = s_len // dilation
    w_sub = window // dilation

    def to_sub(t):
        return t.reshape(b, length, dilation, h, hd).transpose(0, 2, 3, 1, 4).reshape(b * dilation * h, length, hd)

    o, m, s = window_attend(to_sub(q), to_sub(k), to_sub(v), w_sub)
    o = o.reshape(b, dilation, h, length, hd).transpose(0, 3, 1, 2, 4).reshape(b, s_len, h, hd)
    m = m.reshape(b, dilation, h, length).transpose(0, 3, 1, 2).reshape(b, s_len, h)
    s = s.reshape(b, dilation, h, length).transpose(0, 3, 1, 2).reshape(b, s_len, h)
    return o, m, s


def setup_inputs(seed: int = 0) -> dict:
    key = jax.random.key(seed)
    ks = jax.random.split(key, 14)
    f32 = jnp.float32
    nrm = lambda k, shape: jax.random.normal(k, shape, f32)
    x = nrm(ks[0], (BATCH, SEQ, D_MODEL))
    c = nrm(ks[1], (BATCH, D_MODEL))
    w_ada = nrm(ks[2], (DEPTH, D_MODEL, 3 * D_MODEL)) * D_MODEL ** -0.5
    b_ada = 0.02 * nrm(ks[3], (DEPTH, 3 * D_MODEL))
    norm_w = 1.0 + 0.1 * nrm(ks[4], (DEPTH, D_MODEL))
    w_in = nrm(ks[5], (DEPTH, D_MODEL, IN_TOTAL)) * D_MODEL ** -0.5
    conv_w = nrm(ks[6], (DEPTH, CONV_WIDTH, CONV_DIM)) * CONV_WIDTH ** -0.5
    q_norm_w = 1.0 + 0.1 * nrm(ks[7], (DEPTH, HEAD_DIM))
    k_norm_w = 1.0 + 0.1 * nrm(ks[8], (DEPTH, HEAD_DIM))
    w_br_conv = nrm(ks[9], (DEPTH, CONV_DIM, D_MODEL)) * CONV_DIM ** -0.5
    w_br_attn = nrm(ks[10], (DEPTH, ATTN_OUT, D_MODEL)) * ATTN_OUT ** -0.5
    w_out = nrm(ks[11], (DEPTH, D_MODEL, D_MODEL)) * D_MODEL ** -0.5
    return {"x": x, "c": c, "w_ada": w_ada, "b_ada": b_ada, "norm_w": norm_w, "w_in": w_in,
            "conv_w": conv_w, "q_norm_w": q_norm_w, "k_norm_w": k_norm_w,
            "w_br_conv": w_br_conv, "w_br_attn": w_br_attn, "w_out": w_out}


def reference(x, c, w_ada, b_ada, norm_w, w_in, conv_w, q_norm_w, k_norm_w, w_br_conv, w_br_attn, w_out):
    b, s_len, _ = x.shape
    for l in range(DEPTH):
        mod = jax.nn.silu(c) @ w_ada[l] + b_ada[l]
        shift, scale, gate = jnp.split(mod[:, None, :], 3, axis=-1)
        h = rms_norm(x, norm_w[l]) * (1 + scale) + shift

        proj = h @ w_in[l]
        b_a, c_a, x_a, z_a, q, k, v, z_b, g_a, g_b = jnp.split(proj, IN_SPLITS, axis=-1)

        u = c_a * x_a
        conv = lax.conv_general_dilated(u, conv_w[l][:, None, :], window_strides=(1,),
                                        padding=[(CONV_WIDTH - 1, 0)],
                                        dimension_numbers=('NWC', 'WIO', 'NWC'),
                                        feature_group_count=CONV_DIM)
        y_a = b_a * conv * jax.nn.silu(z_a)

        q = rms_norm(q.reshape(b, s_len, N_GROUPS, ATTN_SLOTS, HEAD_DIM), q_norm_w[l])
        k = rms_norm(k.reshape(b, s_len, N_GROUPS, ATTN_SLOTS, HEAD_DIM), k_norm_w[l])
        v = v.reshape(b, s_len, N_GROUPS, ATTN_SLOTS, HEAD_DIM)
        outs, maxes, sums = [], [], []
        for g in range(N_GROUPS):
            o_g, m_g, s_g = dilated_attend(q[:, :, g], k[:, :, g], v[:, :, g], WINDOWS[g], DILATIONS[g])
            outs.append(o_g)
            maxes.append(m_g)
            sums.append(s_g)
        o_all = jnp.stack(outs, axis=0)
        m_all = jnp.stack(maxes, axis=0)
        s_all = jnp.stack(sums, axis=0)
        wgt = jnp.exp(m_all - jnp.max(m_all, axis=0, keepdims=True))
        attn = jnp.sum(wgt[..., None] * o_all, axis=0) / jnp.sum(wgt * s_all, axis=0)[..., None]
        y_b = attn.reshape(b, s_len, ATTN_OUT).astype(x.dtype) * jax.nn.silu(z_b)

        merged = jax.nn.sigmoid(g_a) * (y_a @ w_br_conv[l]) + jax.nn.sigmoid(g_b) * (y_b @ w_br_attn[l])
        x = x + gate * (merged @ w_out[l])
    return x
```

```cpp
#include <hip/hip_runtime.h>
#include <cstdint>
#include <cstdio>

typedef unsigned short bf16;
constexpr int BATCH = 2, SEQ = 8192, DM = 1024, M = BATCH * SEQ, NIN = 11264;
constexpr int OFF_B = 0, OFF_C = 1024, OFF_X = 2048, OFF_Z = 3072, OFF_Q = 4096, OFF_K = 5632, OFF_V = 7168, OFF_ZB = 8704, OFF_GA = 9216, OFF_GB = 10240;
constexpr int QKV = 1536;
constexpr float QSCALE = 0.125f * 1.4426950408889634f;
constexpr float EPS = 1e-6f;
constexpr size_t MiB = 1u << 20;
constexpr size_t WS_CTL = 0, WS_MOD = 512 * 1024;
constexpr size_t WS_XN = 28 * MiB, WS_Q = 60 * MiB, WS_K = 108 * MiB, WS_VT = 156 * MiB, WS_SZ = 204 * MiB, WS_S1 = 220 * MiB, WS_S2 = 236 * MiB;
constexpr size_t WS_SA = 108 * MiB, WS_SB = 140 * MiB, WS_MG = 172 * MiB;

__host__ __device__ __forceinline__ unsigned f2bf(float f) { unsigned u = __builtin_bit_cast(unsigned, f); return (u + 0x7fffu + ((u >> 16) & 1u)) >> 16; }
__host__ __device__ __forceinline__ float bf2f(unsigned h) { return __builtin_bit_cast(float, (h & 0xffffu) << 16); }
__host__ __device__ __forceinline__ float bfr(float f) { return bf2f(f2bf(f)); }
__host__ __device__ __forceinline__ int sigma16(int x) { return (x & 3) | ((x & 4) << 1) | ((x & 8) >> 1); }
__host__ __device__ __forceinline__ int vt_pos(int g, int t) { const int sh = 2 * g, r = t & ((1 << sh) - 1), l = t >> sh, L = SEQ >> sh; return r * L + (l & ~15) + sigma16(l & 15); }
__device__ __forceinline__ float silu_f(float v) { return v / (1.f + __expf(-v)); }
__device__ __forceinline__ float sigm_f(float v) { return 1.f / (1.f + __expf(-v)); }

#define LAS __attribute__((address_space(3)))
#define GAS __attribute__((address_space(1)))
typedef short bf16x8 __attribute__((ext_vector_type(8)));
typedef float f32x4 __attribute__((ext_vector_type(4)));
typedef float f32x16 __attribute__((ext_vector_type(16)));
typedef unsigned u32x4 __attribute__((ext_vector_type(4)));
typedef unsigned u32x2 __attribute__((ext_vector_type(2)));
typedef GAS unsigned gu32;
#define RLX_AGENT __ATOMIC_RELAXED, __HIP_MEMORY_SCOPE_AGENT
#define LDS_WAIT() asm volatile("s_waitcnt lgkmcnt(0)" ::: "memory")
#define VM_WAIT() asm volatile("s_waitcnt vmcnt(0)" ::: "memory")

#ifndef MIDFLAG
#define MIDFLAG true
#endif
#ifndef CHAINFLAG
#define CHAINFLAG true
#endif
constexpr int NWAVES = 8;
constexpr size_t WS_MODP = 256 * 1024;
constexpr size_t WS_MODG = 768 * 1024;
constexpr size_t WS_WALL = 1 * MiB;
constexpr size_t WS_PT = 23 * MiB;
constexpr size_t WS_WOUT = 26 * MiB;
constexpr int ROW_WV = 7680, ROW_WG = 9216;
constexpr int CW_BAR = 4096;
constexpr int RING_BYTES = 131072, ATT_OACC_BYTES = 512 * 65 * 4, ATT_BYTES = ATT_OACC_BYTES + 2048;
constexpr int LDSCTL_OFF = 136192, MISC_OFF = LDSCTL_OFF + 320, LDS_BYTES = 147456;
static_assert(ATT_BYTES <= LDSCTL_OFF && MISC_OFF + 128 <= LDS_BYTES, "LDS map");

__device__ __forceinline__ unsigned cvt_pk_bf16(float lo, float hi) { unsigned r; asm volatile("v_cvt_pk_bf16_f32 %0, %1, %2" : "=v"(r) : "v"(lo), "v"(hi)); return r; }
__device__ __forceinline__ float fast_sigmoid(float v) { return __builtin_amdgcn_rcpf(1.f + __builtin_amdgcn_exp2f(-1.4426950408889634f * v)); }
__device__ __forceinline__ int tau256(int c) { return (c & ~15) + sigma16(c & 15); }
__device__ __forceinline__ int dst_win(int n) {
    if (n < 4096) { const int q = n >> 10, ch = n & 1023, tile = ch >> 6, cl = ch & 63, wc = cl >> 4, fq = (cl >> 2) & 3, i3 = cl & 3, bj = q >> 1, nn = q & 1; return 256 * tile + tau256(128 * bj + 32 * wc + 8 * fq + 4 * nn + i3); }
    if (n < 5632) { const int e = n - 4096, h = e >> 6, dd = e & 63; return 256 * (16 + (h >> 2)) + tau256(128 * (dd >> 5) + 32 * (h & 3) + (dd & 31)); }
    if (n < 7168) { const int e = n - 5632, h = e >> 6, dd = e & 63; return 256 * (22 + (h >> 2)) + tau256(128 * (dd >> 5) + 32 * (h & 3) + (dd & 31)); }
    if (n < 8704) return ROW_WV + (n - 7168);
    if (n < 9216) { const int e = n - 8704; return 256 * (28 + (e >> 8)) + tau256(e & 255); }
    const int e = n - 9216; return ROW_WG + (e & ~255) + tau256(e & 255);
}

#define XB_TMO      128
#define XB_XCNT(j)  (256  + 64 * (j))
#define XB_XSUB(j)  (1280 + 64 * (j))
#define XB_XGEN(j)  (2304 + 64 * (j))
#define XB_TOP      3328
#define XB_TOPGEN   3392
#define XCD_BAR_WORDS 3456
#define XB_SPIN_CAP (1u << 18)
__device__ __forceinline__ unsigned xb_ld(unsigned* p)              { return __hip_atomic_load(p, __ATOMIC_RELAXED, __HIP_MEMORY_SCOPE_AGENT); }
__device__ __forceinline__ unsigned xb_add(unsigned* p, unsigned v) { return __hip_atomic_fetch_add(p, v, __ATOMIC_RELAXED, __HIP_MEMORY_SCOPE_AGENT); }
__device__ __forceinline__ unsigned xb_xcc_id() { return (unsigned)__builtin_amdgcn_s_getreg((3 << 11) | 20) & 0xFu; }
#define XB_SPIN(cond, bar) do { unsigned _sp = 0; while (cond) { __builtin_amdgcn_s_sleep(1); \
    if ((++_sp & 255u) == 0u) { if (xb_ld(&(bar)[XB_TMO])) break; if (_sp > XB_SPIN_CAP) { atomicAdd(&(bar)[XB_TMO], 1u); break; } } } } while (0)
struct XcdBarrier { unsigned* bar; unsigned x; volatile LAS unsigned* st; };
__device__ __forceinline__ XcdBarrier xcd_barrier_post(unsigned* bar, volatile LAS unsigned* st) {
    XcdBarrier b; b.bar = bar; b.x = xb_xcc_id(); b.st = st;
    if (threadIdx.x == 0) (void)xb_add(&bar[XB_XCNT(b.x)], 1u);
    return b;
}
__device__ __forceinline__ void xcd_barrier_complete(unsigned* bar, unsigned x, unsigned& nloc, unsigned& nx) {
    const unsigned G = gridDim.x * gridDim.y * gridDim.z;
    unsigned sum, cnt, mine, sp = 0u;
    for (;;) {
        sum = 0u; cnt = 0u; mine = 0u;
#pragma unroll
        for (unsigned j = 0; j < 16; ++j) { const unsigned c = xb_ld(&bar[XB_XCNT(j)]); sum += c; cnt += (c > 0u) ? 1u : 0u; mine = (j == x) ? c : mine; }
        if (sum == G) break;
        __builtin_amdgcn_s_sleep(1);
        if ((++sp & 255u) == 0u) { if (xb_ld(&bar[XB_TMO])) break; if (sp > XB_SPIN_CAP) { atomicAdd(&bar[XB_TMO], 1u); break; } }
    }
    nloc = mine > 0u ? mine : 1u; nx = cnt > 0u ? cnt : 1u;
}
__device__ __forceinline__ void xcd_barrier(const XcdBarrier& b) {
    asm volatile("s_waitcnt vmcnt(0)" ::: "memory");
    __syncthreads();
    if (threadIdx.x == 0) {
        unsigned* bar = b.bar;
        __builtin_amdgcn_s_waitcnt(0);
        unsigned nloc = b.st[0], nx = b.st[1];
        if (nloc == 0u) { xcd_barrier_complete(bar, b.x, nloc, nx); b.st[0] = nloc; b.st[1] = nx; }
        const unsigned old = xb_add(&bar[XB_XSUB(b.x)], 1u);
        const unsigned gen = old / nloc;
        if (old + 1u == (gen + 1u) * nloc) {
            __builtin_amdgcn_fence(__ATOMIC_RELEASE, "agent");
            asm volatile("s_waitcnt vmcnt(0)" ::: "memory");
            const unsigned og = xb_add(&bar[XB_TOP], 1u);
            const unsigned tg = og / nx;
            if (og + 1u == (tg + 1u) * nx) xb_add(&bar[XB_TOPGEN], 1u);
            else XB_SPIN(xb_ld(&bar[XB_TOPGEN]) == tg, bar);
            __builtin_amdgcn_fence(__ATOMIC_ACQUIRE, "agent");
            xb_add(&bar[XB_XGEN(b.x)], 1u);
            asm volatile("s_waitcnt vmcnt(0)" ::: "memory");
        } else {
            XB_SPIN(xb_ld(&bar[XB_XGEN(b.x)]) == gen, bar);
            __builtin_amdgcn_fence(__ATOMIC_ACQUIRE, "agent");
            asm volatile("s_waitcnt vmcnt(0)" ::: "memory");
        }
    }
    __syncthreads();
}

namespace pg8 {
constexpr int BM = 256, BK = 64, HALF = 128, HTB = HALF * BK * 2, NXCD = 8, WGM = 8;
__host__ __device__ __forceinline__ int lds_byte(int r, int c) { const int st = (r >> 4) * 2 + (c >> 5), rr = r & 15, cc = c & 31, ob = rr * 64 + cc * 2; return st * 1024 + (ob ^ (((ob >> 9) & 1) << 5)); }
__host__ __device__ __forceinline__ void stage_rc(int b, int& R, int& C) { const int st = b / 1024, sb = b % 1024, swz = sb ^ (((sb >> 9) & 1) << 5); R = (st >> 1) * 16 + swz / 64; C = (st & 1) * 32 + (swz % 64) / 2; }
__host__ __device__ __forceinline__ int perm32(int rho) { const int n = rho >> 4, i = rho & 15; return 8 * (i >> 2) + 4 * n + (i & 3); }
__device__ __forceinline__ void tile_of(int L, int nM, int nN, int& pm, int& pn) {
    const int nwg = nM * nN; int wgid = L; { const int q = nwg / NXCD, r = nwg % NXCD, xcd = wgid % NXCD, off = wgid / NXCD; wgid = (xcd < r ? xcd * (q + 1) : r * (q + 1) + (xcd - r) * q) + off; }
    const int nig = WGM * nN, gid = wgid / nig, fm = gid * WGM, gsz = (nM - fm) < WGM ? (nM - fm) : WGM;
    pm = fm + ((wgid % nig) % gsz); pn = (wgid % nig) / gsz;
}
enum { K_CONV = 0, K_Q, K_K, K_ZB, K_V, K_GA, K_GB, K_MB, K_MERGE, K_OUT };
struct UnitD { const char* A; const char* B; unsigned pA, pB; int nt, kind, pm, pn; };

template <class Epi, class Sched>
__device__ __forceinline__ void gemm_phase(LAS unsigned char* lds, const Sched& S, const Epi& E) {
    const int tid = threadIdx.x, wid = __builtin_amdgcn_readfirstlane(tid >> 6), lane = tid & 63, wr = wid >> 2, wc = wid & 3, fr = lane & 15, fq = lane >> 4;
    unsigned rowA[2], rowB[2], col2[2];
#pragma unroll
    for (int i = 0; i < 2; ++i) { int R, C; stage_rc(tid * 16 + i * 8192, R, C); const int Rb = (R & ~31) + perm32(R & 31);
        rowA[i] = (unsigned)R; rowB[i] = (unsigned)tau256(Rb); col2[i] = (unsigned)C * 2u; }
    const size_t kstep = (size_t)(BK * 2);
    const unsigned ldsw = (unsigned)wid * 1024u;
    const int aoff = lds_byte(wr * 64 + fr, fq * 8), boff = lds_byte(wc * 32 + fr, fq * 8);
#define PG8_SA(b, h) (((b) * 2 + (h)) * HTB)
#define PG8_SB(b, h) ((4 + (b) * 2 + (h)) * HTB)
#define PG8_STAGE(bufoff, gbase, rowv, pitch) do { _Pragma("unroll") for (int _i = 0; _i < 2; ++_i) \
        __builtin_amdgcn_global_load_lds((const unsigned*)((const char*)(gbase) + (rowv[_i] * (pitch) + col2[_i])), (LAS unsigned*)(lds + (bufoff) + ldsw + _i * 8192), 16, 0, 0); } while (0)
#define PG8_LDA(dst, b, h) do { _Pragma("unroll") for (int m = 0; m < 4; ++m) _Pragma("unroll") for (int k = 0; k < 2; ++k) dst[m][k] = *(const LAS bf16x8*)(lds + PG8_SA(b, h) + aoff + m * 2048 + k * 1024); } while (0)
#define PG8_LDB(dst, b, h) do { _Pragma("unroll") for (int n = 0; n < 2; ++n) _Pragma("unroll") for (int k = 0; k < 2; ++k) dst[n][k] = *(const LAS bf16x8*)(lds + PG8_SB(b, h) + boff + n * 2048 + k * 1024); } while (0)
#define PG8_MMA(ai, bj, At, Bt) do { __builtin_amdgcn_s_setprio(1); _Pragma("unroll") for (int m = 0; m < 4; ++m) _Pragma("unroll") for (int n = 0; n < 2; ++n) _Pragma("unroll") for (int k = 0; k < 2; ++k) \
        acc[ai][bj][m][n] = __builtin_amdgcn_mfma_f32_16x16x32_bf16(Bt[n][k], At[m][k], acc[ai][bj][m][n], 0, 0, 0); __builtin_amdgcn_s_setprio(0); } while (0)
#define PG8_WAIT_V(n) asm volatile("s_waitcnt vmcnt(" #n ")" ::: "memory")
#define PG8_WAIT_L(n) asm volatile("s_waitcnt lgkmcnt(" #n ")" ::: "memory")
#define PG8_BAR __builtin_amdgcn_s_barrier()
#define PG8_SCHED __builtin_amdgcn_sched_barrier(0)
    UnitD cur, nxt; int ui = 0;
    if (!S.next(0, cur)) return;
    f32x4 acc[2][2][4][2];
#pragma unroll
    for (int a = 0; a < 2; ++a)
#pragma unroll
        for (int b = 0; b < 2; ++b)
#pragma unroll
            for (int m = 0; m < 4; ++m)
#pragma unroll
                for (int n = 0; n < 2; ++n) acc[a][b][m][n] = (f32x4){0.f, 0.f, 0.f, 0.f};
    bf16x8 At[4][2], B0[2][2], B1[2][2];
    const char* cA = cur.A; const char* cB = cur.B;
    {   const unsigned pA = cur.pA, pB = cur.pB; const size_t hA = (size_t)HALF * pA, hB = (size_t)HALF * pB;
        PG8_STAGE(PG8_SB(0, 0), cB, rowB, pB); PG8_STAGE(PG8_SB(0, 1), cB + hB, rowB, pB); PG8_STAGE(PG8_SA(0, 0), cA, rowA, pA); PG8_STAGE(PG8_SA(0, 1), cA + hA, rowA, pA);
        if (wr == 1) PG8_BAR;
        PG8_WAIT_V(2); PG8_BAR;
        PG8_STAGE(PG8_SB(1, 0), cB + kstep, rowB, pB); PG8_STAGE(PG8_SA(1, 0), cA + kstep, rowA, pA); PG8_STAGE(PG8_SB(1, 1), cB + hB + kstep, rowB, pB);
        PG8_WAIT_V(6); PG8_BAR;
    }
    for (;;) {
        const bool has_next = S.next(ui + 1, nxt);
        const char* nA = has_next ? nxt.A : cA; const char* nB = has_next ? nxt.B : cB;
        const unsigned npA = has_next ? nxt.pA : cur.pA, npB = has_next ? nxt.pB : cur.pB;
        const unsigned pA = cur.pA; const size_t hA = (size_t)HALF * pA;
        const int nt = cur.nt;
        for (int t = 0; t < nt; t += 2) {
            const bool last = (t == nt - 2);
            const char* a1 = cA + (size_t)(t + 1) * kstep;
            const char* a2 = last ? nA : cA + (size_t)(t + 2) * kstep; const char* b2 = last ? nB : cB + (size_t)(t + 2) * kstep;
            const unsigned p2A = last ? npA : pA, p2B = last ? npB : cur.pB; const size_t h2A = (size_t)HALF * p2A, h2B = (size_t)HALF * p2B;
            const char* a3 = a2 + kstep; const char* b3 = b2 + kstep;
            PG8_LDB(B0, 0, 0); PG8_LDB(B1, 0, 1); PG8_SCHED; PG8_LDA(At, 0, 0); PG8_STAGE(PG8_SA(1, 1), a1 + hA, rowA, pA);
            PG8_WAIT_V(8); PG8_WAIT_L(0); PG8_BAR; PG8_MMA(0, 0, At, B0); PG8_MMA(0, 1, At, B1); PG8_BAR; PG8_SCHED;
            PG8_LDA(At, 0, 1); PG8_STAGE(PG8_SB(0, 0), b2, rowB, p2B); PG8_STAGE(PG8_SB(0, 1), b2 + h2B, rowB, p2B); PG8_STAGE(PG8_SA(0, 0), a2, rowA, p2A);
            PG8_WAIT_V(8); PG8_WAIT_L(0); PG8_BAR; PG8_MMA(1, 0, At, B0); PG8_MMA(1, 1, At, B1); PG8_BAR; PG8_SCHED;
            PG8_LDB(B0, 1, 0); PG8_LDB(B1, 1, 1); PG8_SCHED; PG8_LDA(At, 1, 0); PG8_STAGE(PG8_SA(0, 1), a2 + h2A, rowA, p2A);
            PG8_WAIT_V(8); PG8_WAIT_L(0); PG8_BAR; PG8_MMA(0, 0, At, B0); PG8_MMA(0, 1, At, B1); PG8_BAR; PG8_SCHED;
            PG8_LDA(At, 1, 1); PG8_STAGE(PG8_SB(1, 0), b3, rowB, p2B); PG8_STAGE(PG8_SB(1, 1), b3 + h2B, rowB, p2B); PG8_STAGE(PG8_SA(1, 0), a3, rowA, p2A);
            PG8_WAIT_V(8); PG8_WAIT_L(0); PG8_BAR; PG8_MMA(1, 0, At, B0); PG8_MMA(1, 1, At, B1); PG8_BAR; PG8_SCHED;
        }
        if (wr == 0) PG8_BAR;
        if (Epi::HAS_CHAIN && cur.kind == K_MB) { E.rescale(acc, cur, wr, wc, fr, fq); }
        else {
        E(acc, cur, wr, wc, fr, fq);
        if (!has_next) break;
#pragma unroll
        for (int a = 0; a < 2; ++a)
#pragma unroll
            for (int b = 0; b < 2; ++b)
#pragma unroll
                for (int m = 0; m < 4; ++m)
#pragma unroll
                    for (int n = 0; n < 2; ++n) acc[a][b][m][n] = (f32x4){0.f, 0.f, 0.f, 0.f};
        }
        cur = nxt; cA = nA; cB = nB; ++ui;
        if (wr == 1) PG8_BAR;
    }
    PG8_WAIT_V(0);
    PG8_BAR;
#undef PG8_SA
#undef PG8_SB
#undef PG8_STAGE
#undef PG8_LDA
#undef PG8_LDB
#undef PG8_MMA
#undef PG8_WAIT_V
#undef PG8_WAIT_L
#undef PG8_BAR
#undef PG8_SCHED
}

__device__ __forceinline__ u32x4 pack8(const f32x4 a, const f32x4 b) { u32x4 w; w.x = cvt_pk_bf16(a[0], a[1]); w.y = cvt_pk_bf16(a[2], a[3]); w.z = cvt_pk_bf16(b[0], b[1]); w.w = cvt_pk_bf16(b[2], b[3]); return w; }
__device__ __forceinline__ void unpack8(const u32x4 w, f32x4& a, f32x4& b) {
    a[0] = __uint_as_float(w.x << 16); a[1] = __uint_as_float(w.x & 0xffff0000u); a[2] = __uint_as_float(w.y << 16); a[3] = __uint_as_float(w.y & 0xffff0000u);
    b[0] = __uint_as_float(w.z << 16); b[1] = __uint_as_float(w.z & 0xffff0000u); b[2] = __uint_as_float(w.w << 16); b[3] = __uint_as_float(w.w & 0xffff0000u); }

#define LD16(base, off) (*(const u32x4*)((const char*)(base) + (unsigned)(off)))
#define ST16(base, off, v) (*(u32x4*)((char*)(base) + (unsigned)(off)) = (v))
struct EpiG1 {
    static constexpr bool HAS_CHAIN = false;
    __device__ __forceinline__ void rescale(f32x4 (&)[2][2][4][2], const UnitD&, int, int, int, int) const {}
    bf16* UB; bf16* Qn; bf16* Kn; bf16* VT; bf16* SZ; const float* wq; const float* wk;
    __device__ __forceinline__ void operator()(f32x4 (&acc)[2][2][4][2], const UnitD& u, int wr, int wc, int fr, int fq) const {
        const unsigned row0 = (unsigned)(u.pm * BM + wr * 64 + fr);
        if (u.kind == K_CONV) {
            const unsigned o0 = row0 * 4096u + (unsigned)(16 * u.pn + 4 * wc + fq) * 16u;
#pragma unroll
            for (int ai = 0; ai < 2; ++ai)
#pragma unroll
                for (int m = 0; m < 4; ++m) { const f32x4 b = acc[ai][0][m][0], c = acc[ai][0][m][1], x = acc[ai][1][m][0], z = acc[ai][1][m][1]; f32x4 uu = c * x, bz;
#pragma unroll
                    for (int i = 0; i < 4; ++i) bz[i] = b[i] * z[i] * fast_sigmoid(z[i]);
                    ST16(UB, o0 + (unsigned)(ai * HALF + m * 16) * 4096u, pack8(uu, bz)); }
        } else if (u.kind == K_Q || u.kind == K_K) {
            const bool isq = (u.kind == K_Q); const float* w = isq ? wq : wk; const float sc = isq ? QSCALE : 1.0f; bf16* dst = isq ? Qn : Kn;
            const unsigned o0 = row0 * (unsigned)(QKV * 2) + (unsigned)((4 * u.pn + wc) * 64 + 8 * fq) * 2u;
            f32x4 wv[2][2];
#pragma unroll
            for (int bj = 0; bj < 2; ++bj)
#pragma unroll
                for (int n = 0; n < 2; ++n) wv[bj][n] = *(const f32x4*)(w + 32 * bj + 8 * fq + 4 * n);
#pragma unroll
            for (int ai = 0; ai < 2; ++ai)
#pragma unroll
                for (int m = 0; m < 4; ++m) { float ss = 0.f;
#pragma unroll
                    for (int bj = 0; bj < 2; ++bj)
#pragma unroll
                        for (int n = 0; n < 2; ++n) { const f32x4 v = acc[ai][bj][m][n]; ss += (v[0] * v[0] + v[1] * v[1]) + (v[2] * v[2] + v[3] * v[3]); }
                    ss += __shfl_xor(ss, 16); ss += __shfl_xor(ss, 32);
                    const float r = __builtin_amdgcn_rsqf(ss * (1.f / 64.f) + EPS) * sc; const unsigned o = o0 + (unsigned)(ai * HALF + m * 16) * (unsigned)(QKV * 2);
#pragma unroll
                    for (int bj = 0; bj < 2; ++bj) ST16(dst, o + 64u * bj, pack8(acc[ai][bj][m][0] * r * wv[bj][0], acc[ai][bj][m][1] * r * wv[bj][1])); }
        } else if (u.kind == K_ZB) {
            const unsigned o0 = row0 * 1024u + (unsigned)(256 * u.pn + 32 * wc + 8 * fq) * 2u;
#pragma unroll
            for (int ai = 0; ai < 2; ++ai)
#pragma unroll
                for (int m = 0; m < 4; ++m)
#pragma unroll
                    for (int bj = 0; bj < 2; ++bj) { f32x4 v0 = acc[ai][bj][m][0], v1 = acc[ai][bj][m][1];
#pragma unroll
                        for (int i = 0; i < 4; ++i) { v0[i] = v0[i] * fast_sigmoid(v0[i]); v1[i] = v1[i] * fast_sigmoid(v1[i]); }
                        ST16(SZ, o0 + (unsigned)(ai * HALF + m * 16) * 1024u + 256u * bj, pack8(v0, v1)); }
        } else {
            const unsigned o0 = row0 * (unsigned)(M * 2) + (unsigned)(256 * u.pn + 32 * wc + 8 * fq) * 2u;
#pragma unroll
            for (int ai = 0; ai < 2; ++ai)
#pragma unroll
                for (int m = 0; m < 4; ++m)
#pragma unroll
                    for (int bj = 0; bj < 2; ++bj) ST16(VT, o0 + (unsigned)(ai * HALF + m * 16) * (unsigned)(M * 2) + 256u * bj, pack8(acc[ai][bj][m][0], acc[ai][bj][m][1]));
        }
    }
};
struct EpiG2 {
    static constexpr bool HAS_CHAIN = false;
    bf16* SA; bf16* SB; bf16* MG; float* T;
    __device__ __forceinline__ void rescale(f32x4 (&)[2][2][4][2], const UnitD&, int, int, int, int) const {}
    __device__ __forceinline__ void operator()(f32x4 (&acc)[2][2][4][2], const UnitD& u, int wr, int wc, int fr, int fq) const {
        const unsigned o0 = (unsigned)(u.pm * BM + wr * 64 + fr) * 2048u + (unsigned)(256 * u.pn + 32 * wc + 8 * fq) * 2u;
        if (u.kind == K_MB) {
#pragma unroll
            for (int ai = 0; ai < 2; ++ai)
#pragma unroll
                for (int m = 0; m < 4; ++m)
#pragma unroll
                    for (int bj = 0; bj < 2; ++bj) { const unsigned o = o0 + (unsigned)(ai * HALF + m * 16) * 2048u + 256u * bj; f32x4 b0, b1; unpack8(LD16(SB, o), b0, b1);
                        *(f32x4*)((char*)T + 2u * o) = acc[ai][bj][m][0] * b0; *(f32x4*)((char*)T + 2u * o + 16u) = acc[ai][bj][m][1] * b1; if (bj == 1) asm volatile("" ::: "memory"); }
        } else if (u.kind == K_MERGE) {
#pragma unroll
            for (int ai = 0; ai < 2; ++ai)
#pragma unroll
                for (int m = 0; m < 4; ++m)
#pragma unroll
                    for (int bj = 0; bj < 2; ++bj) { const unsigned o = o0 + (unsigned)(ai * HALF + m * 16) * 2048u + 256u * bj; f32x4 a0, a1; unpack8(LD16(SA, o), a0, a1);
                        const f32x4 t0 = *(const f32x4*)((const char*)T + 2u * o), t1 = *(const f32x4*)((const char*)T + 2u * o + 16u);
                        ST16(MG, o, pack8(acc[ai][bj][m][0] * a0 + t0, acc[ai][bj][m][1] * a1 + t1)); if (bj == 1) asm volatile("" ::: "memory"); }
        } else {
            const bool isa = (u.kind == K_GA); bf16* dst = isa ? SA : SB; const float lo = 0.f;
#pragma unroll
            for (int ai = 0; ai < 2; ++ai)
#pragma unroll
                for (int m = 0; m < 4; ++m)
#pragma unroll
                    for (int bj = 0; bj < 2; ++bj) { f32x4 v0 = acc[ai][bj][m][0], v1 = acc[ai][bj][m][1];
#pragma unroll
                        for (int i = 0; i < 4; ++i) { v0[i] = fmaxf(fast_sigmoid(v0[i]), lo); v1[i] = fmaxf(fast_sigmoid(v1[i]), lo); }
                        ST16(dst, o0 + (unsigned)(ai * HALF + m * 16) * 2048u + 256u * bj, pack8(v0, v1)); }
        }
    }
};
struct EpiG3 {
    static constexpr bool HAS_CHAIN = false;
    __device__ __forceinline__ void rescale(f32x4 (&)[2][2][4][2], const UnitD&, int, int, int, int) const {}
    const float* x; float* out; const float* gate;
    __device__ __forceinline__ void operator()(f32x4 (&acc)[2][2][4][2], const UnitD& u, int wr, int wc, int fr, int fq) const {
        const int col0 = 256 * u.pn + 32 * wc + 8 * fq; const float* gp = gate + (u.pm >> 5) * DM + col0;
        f32x4 gv[2][2];
#pragma unroll
        for (int bj = 0; bj < 2; ++bj)
#pragma unroll
            for (int n = 0; n < 2; ++n) gv[bj][n] = *(const f32x4*)(gp + bj * HALF + 4 * n);
        const unsigned o0 = (unsigned)(u.pm * BM + wr * 64 + fr) * 4096u + (unsigned)col0 * 4u;
#pragma unroll
        for (int ai = 0; ai < 2; ++ai)
#pragma unroll
            for (int m = 0; m < 4; ++m) {
#pragma unroll
                for (int bj = 0; bj < 2; ++bj)
#pragma unroll
                    for (int n = 0; n < 2; ++n) { const unsigned o = o0 + (unsigned)(ai * HALF + m * 16) * 4096u + 512u * bj + 16u * n;
                        *(f32x4*)((char*)out + o) = *(const f32x4*)((const char*)x + o) + gv[bj][n] * acc[ai][bj][m][n]; }
                if (m & 1) asm volatile("" ::: "memory"); }
    }
};
struct SchedG1 {
    const char* XN; const char* WALL; int G, c;
    __device__ __forceinline__ bool next(int i, UnitD& u) const {
        const int L = i * G + c; if (L >= 2304) return false;
        if (L < 1920) { int pm, pn; tile_of(L, 64, 30, pm, pn); u.A = XN + (size_t)pm * (256 * 2048); u.B = WALL + (size_t)pn * (256 * 2048); u.pA = 2048u; u.pB = 2048u; u.nt = 16; u.pm = pm;
            if (pn < 16) { u.kind = K_CONV; u.pn = pn; } else if (pn < 22) { u.kind = K_Q; u.pn = pn - 16; } else if (pn < 28) { u.kind = K_K; u.pn = pn - 22; } else { u.kind = K_ZB; u.pn = pn - 28; }
        } else { int pm, pn; tile_of(L - 1920, 6, 64, pm, pn); const int sh = 2 * (pm >> 1), b = pn >> 5, q = pn & 31, tpr = 32 >> sh, r = q / tpr, l0 = 256 * (q % tpr);
            u.A = WALL + (size_t)(ROW_WV + 256 * pm) * 2048; u.B = XN + (size_t)(b * SEQ + (l0 << sh) + r) * 2048; u.pA = 2048u; u.pB = 2048u << sh; u.nt = 16; u.kind = K_V; u.pm = pm; u.pn = pn; }
        return true;
    }
};
struct SchedG2 {
    const char* XN; const char* WALL; const char* Y; const char* PT; int G, c;
    __device__ __forceinline__ bool next(int i, UnitD& u) const {
        const int j = i >> 2, sub = i & 3, L = j * G + c; if (L >= 256) return false;
        int pm, pn; tile_of(L, 64, 4, pm, pn); u.pm = pm; u.pn = pn;
        if (sub < 2) { u.A = XN + (size_t)pm * (256 * 2048); u.B = WALL + (size_t)(ROW_WG + 1024 * sub + 256 * pn) * 2048; u.pA = 2048u; u.pB = 2048u; u.nt = 16; u.kind = sub == 0 ? K_GA : K_GB; }
        else if (sub == 2) { u.A = Y + (size_t)pm * (256 * 3072); u.B = PT + (size_t)pn * (256 * 3072); u.pA = 3072u; u.pB = 3072u; u.nt = 8; u.kind = K_MB; }
        else { u.A = Y + (size_t)pm * (256 * 3072) + 1024; u.B = PT + (size_t)pn * (256 * 3072) + 1024; u.pA = 3072u; u.pB = 3072u; u.nt = 16; u.kind = K_MERGE; }
        return true;
    }
};
struct SchedG3 {
    const char* MGp; const char* WOUT; int G, c;
    __device__ __forceinline__ bool next(int i, UnitD& u) const {
        const int L = i * G + c; if (L >= 256) return false;
        int pm, pn; tile_of(L, 64, 4, pm, pn); u.pm = pm; u.pn = pn; u.A = MGp + (size_t)pm * (256 * 2048); u.B = WOUT + (size_t)pn * (256 * 2048); u.pA = 2048u; u.pB = 2048u; u.nt = 16; u.kind = K_OUT; return true;
    }
};
}

struct Frame {
    LAS unsigned char* lds; volatile LAS unsigned* MISC; gu32* ctl;
    int tid, lane, wave, vcu, G;
};
struct Args { const float* in[12]; float* out; unsigned char* ws; int ph_lo, ph_hi, li, pad; };

__device__ __forceinline__ float wave_sum(float v) {
#pragma unroll
    for (int o = 1; o < 64; o <<= 1) v += __shfl_xor(v, o);
    return v;
}
template <class RowMap>
__device__ __forceinline__ void p0_transpose_item(const float* W, int N, bf16* WT, int pitch, int koff, LAS float* scr, int k0, int n0, int lane, const RowMap& rm) {
#pragma unroll 8
    for (int i = 0; i < 32; ++i) { const int kk = 2 * i + (lane >> 5); scr[kk * 33 + (lane & 31)] = W[(size_t)(k0 + kk) * N + n0 + (lane & 31)]; }
    LDS_WAIT(); asm volatile("" ::: "memory");
    const int c = lane & 7;
#pragma unroll
    for (int j = 0; j < 4; ++j) { const int n = (lane >> 3) + 8 * j; const LAS float* s = scr + (8 * c) * 33 + n;
        u32x4 o; o.x = cvt_pk_bf16(s[0 * 33], s[1 * 33]); o.y = cvt_pk_bf16(s[2 * 33], s[3 * 33]); o.z = cvt_pk_bf16(s[4 * 33], s[5 * 33]); o.w = cvt_pk_bf16(s[6 * 33], s[7 * 33]);
        *(GAS u32x4*)(WT + (size_t)rm(n0 + n) * pitch + koff + k0 + 8 * c) = o; }
    LDS_WAIT(); asm volatile("" ::: "memory");
}
struct RmWin { __device__ __forceinline__ int operator()(int n) const { return dst_win(n); } };
struct RmTau { __device__ __forceinline__ int operator()(int n) const { return (n & ~255) + tau256(n & 255); } };

__device__ __forceinline__ void p0a(Frame& F, const Args& a) {
    LAS float* scr = (LAS float*)(F.lds + F.wave * 16384);
    const int gw = F.vcu * NWAVES + F.wave, NGW = F.G * NWAVES;
    const float* w_in = a.in[5]; const float* w_brc = a.in[9]; const float* w_bra = a.in[10]; const float* w_out = a.in[11];
    bf16* WALL = (bf16*)(a.ws + WS_WALL); bf16* PT = (bf16*)(a.ws + WS_PT); bf16* WOUT = (bf16*)(a.ws + WS_WOUT);
    constexpr int I_IN = 16 * 352, I_C = 16 * 32, I_A = 8 * 32, I_O = 16 * 32, NITEMS = I_IN + I_C + I_A + I_O;
    { const float* c = a.in[1]; const float* w_ada = a.in[2]; float* modp = (float*)(a.ws + WS_MODP);
      for (int it = gw; it < 768; it += NGW) { const int cch = it % 96, ks = it / 96, col = 32 * cch + (F.lane & 31), kb = ks * 128 + (F.lane >> 5) * 64; float a0 = 0.f, a1 = 0.f;
#pragma unroll 8
          for (int i = 0; i < 64; ++i) { const int k = kb + i; const float w = w_ada[(size_t)k * 3072 + col], c0 = c[k], c1 = c[DM + k]; a0 += c0 * fast_sigmoid(c0) * w; a1 += c1 * fast_sigmoid(c1) * w; }
          a0 += __shfl_xor(a0, 32); a1 += __shfl_xor(a1, 32);
          if (F.lane < 32) { modp[(size_t)(ks * 2 + 0) * 3072 + col] = a0; modp[(size_t)(ks * 2 + 1) * 3072 + col] = a1; } } }
    for (int it = gw; it < NITEMS; it += NGW) {
        int r = it;
        if (r < I_IN) { p0_transpose_item(w_in, NIN, WALL, 1024, 0, scr, 64 * (r / 352), 32 * (r % 352), F.lane, RmWin()); continue; } r -= I_IN;
        if (r < I_C) { p0_transpose_item(w_brc, DM, PT, 1536, 512, scr, 64 * (r / 32), 32 * (r % 32), F.lane, RmTau()); continue; } r -= I_C;
        if (r < I_A) { p0_transpose_item(w_bra, DM, PT, 1536, 0, scr, 64 * (r / 32), 32 * (r % 32), F.lane, RmTau()); continue; } r -= I_A;
        p0_transpose_item(w_out, DM, WOUT, 1024, 0, scr, 64 * (r / 32), 32 * (r % 32), F.lane, RmTau());
    }
}
__device__ __forceinline__ void p0b(Frame& F, const Args& a) {
    const float* x = a.in[0]; const float* b_ada = a.in[3]; const float* norm_w = a.in[4]; const float* modp = (const float*)(a.ws + WS_MODP);
    bf16* XN = (bf16*)(a.ws + WS_XN); float* modg = (float*)(a.ws + WS_MODG);
    LAS float* tg = (LAS float*)F.lds; LAS float* ts = tg + 1024;
    int curb = -1;
    for (int blk = F.vcu; blk < M / 64; blk += F.G) {
        const int b = blk / (SEQ / 64);
        if (b != curb) { __syncthreads();
            for (int k = F.tid; k < 2048; k += NWAVES * 64) { const int col = (k < 1024) ? 1024 + k : k - 1024; float s = b_ada[col];
#pragma unroll
                for (int ks = 0; ks < 8; ++ks) s += modp[(size_t)(ks * 2 + b) * 3072 + col];
                if (k < 1024) tg[k] = norm_w[k] * (1.f + s); else ts[k - 1024] = s; }
            __syncthreads(); curb = b; }
#pragma unroll 2
        for (int i = 0; i < 8; ++i) { const int m = blk * 64 + F.wave * 8 + i; const GAS f32x4* xr = (const GAS f32x4*)(x + (size_t)m * DM) + F.lane;
            f32x4 v[4]; float ss = 0.f;
#pragma unroll
            for (int j = 0; j < 4; ++j) { v[j] = xr[64 * j]; ss += (v[j][0] * v[j][0] + v[j][1] * v[j][1]) + (v[j][2] * v[j][2] + v[j][3] * v[j][3]); }
            const float rstd = __builtin_amdgcn_rsqf(wave_sum(ss) * (1.f / DM) + EPS);
            GAS u32x2* o8 = (GAS u32x2*)(XN + (size_t)m * DM) + F.lane;
#pragma unroll
            for (int j = 0; j < 4; ++j) { const f32x4 g = *(const LAS f32x4*)(tg + 4 * F.lane + 256 * j), s = *(const LAS f32x4*)(ts + 4 * F.lane + 256 * j); const f32x4 h = v[j] * rstd * g + s;
                u32x2 w; w.x = cvt_pk_bf16(h[0], h[1]); w.y = cvt_pk_bf16(h[2], h[3]); o8[64 * j] = w; } }
    }
    if (F.vcu == 0) for (int k = F.tid; k < 2048; k += NWAVES * 64) { const int b = k >> 10, col = 2048 + (k & 1023); float s = b_ada[col];
#pragma unroll
        for (int ks = 0; ks < 8; ++ks) s += modp[(size_t)(ks * 2 + b) * 3072 + col];
        modg[k] = s; }
    __syncthreads();
}

__device__ __forceinline__ int rho512(int t) { return (t & ~31) | ((t ^ (t >> 5)) & 31); }
__device__ __forceinline__ void attn_tile(LAS float* Oacc, LAS float* Lacc, const bf16* Qn, const bf16* Kn, const bf16* VT, int b, int j, int T0, int ti, int lane, float shift) {
    const int g = ti >> 4, tt = ti & 15, sh = 2 * g, r32 = lane & 31, h = lane >> 5;
    int r, lq0;
    if (g == 0) { r = 0; lq0 = T0 + 32 * tt; } else if (g == 1) { r = tt >> 2; lq0 = (T0 >> 2) + 32 * (tt & 3); } else { r = tt; lq0 = T0 >> 4; }
    const int head = g * 8 + j, L = SEQ >> sh;
    const int tq = ((lq0 + r32) << sh) + r;
    const GAS bf16x8* qp = (const GAS bf16x8*)(Qn + (size_t)(b * SEQ + tq) * QKV + head * 64 + 8 * h);
    bf16x8 qf[4];
#pragma unroll
    for (int s = 0; s < 4; ++s) qf[s] = qp[2 * s];
    f32x16 o0 = {}, o1 = {}; float lsum = 0.f;
    const int kl0 = lq0 - 128;
    const bf16* vbase = VT + (size_t)(head * 64 + r32) * M + b * SEQ + r * L + 8 * h;
#pragma unroll
    for (int kb = 0; kb < 5; ++kb) {
        const int klb = kl0 + 32 * kb;
        if (klb >= 0) {
            const int tk = ((klb + r32) << sh) + r;
            const GAS bf16x8* kp = (const GAS bf16x8*)(Kn + (size_t)(b * SEQ + tk) * QKV + head * 64 + 8 * h);
            bf16x8 kf[4];
#pragma unroll
            for (int s = 0; s < 4; ++s) kf[s] = kp[2 * s];
            const GAS bf16x8* vp = (const GAS bf16x8*)(vbase + klb);
            const bf16x8 v00 = vp[0], v01 = vp[2];
            const GAS bf16x8* vp1 = (const GAS bf16x8*)(vbase + (size_t)32 * M + klb);
            const bf16x8 v10 = vp1[0], v11 = vp1[2];
            f32x16 sacc = {};
#pragma unroll
            for (int s = 0; s < 4; ++s) sacc = __builtin_amdgcn_mfma_f32_32x32x16_bf16(kf[s], qf[s], sacc, 0, 0, 0);
            float p[16];
#pragma unroll
            for (int rg = 0; rg < 16; ++rg) { const int kk = (rg & 3) + 8 * (rg >> 2) + 4 * h; float e = __builtin_amdgcn_exp2f(sacc[rg] - shift);
                if (kb == 0) e = (kk >= r32) ? e : 0.f;
                if (kb == 4) e = (kk <= r32) ? e : 0.f;
                p[rg] = e; lsum += e; }
            u32x4 w0, w1; w0.x = cvt_pk_bf16(p[0], p[1]); w0.y = cvt_pk_bf16(p[2], p[3]); w0.z = cvt_pk_bf16(p[4], p[5]); w0.w = cvt_pk_bf16(p[6], p[7]);
            w1.x = cvt_pk_bf16(p[8], p[9]); w1.y = cvt_pk_bf16(p[10], p[11]); w1.z = cvt_pk_bf16(p[12], p[13]); w1.w = cvt_pk_bf16(p[14], p[15]);
            const bf16x8 pf0 = __builtin_bit_cast(bf16x8, w0), pf1 = __builtin_bit_cast(bf16x8, w1);
            o0 = __builtin_amdgcn_mfma_f32_32x32x16_bf16(v00, pf0, o0, 0, 0, 0); o0 = __builtin_amdgcn_mfma_f32_32x32x16_bf16(v01, pf1, o0, 0, 0, 0);
            o1 = __builtin_amdgcn_mfma_f32_32x32x16_bf16(v10, pf0, o1, 0, 0, 0); o1 = __builtin_amdgcn_mfma_f32_32x32x16_bf16(v11, pf1, o1, 0, 0, 0);
        }
    }
    const int rho = rho512(tq - T0); LAS float* op = Oacc + rho * 65 + 4 * h;
#pragma unroll
    for (int rg = 0; rg < 16; ++rg) { const int dd = (rg & 3) + 8 * (rg >> 2);
        __hip_atomic_fetch_add(op + dd, o0[rg], __ATOMIC_RELAXED, __HIP_MEMORY_SCOPE_WORKGROUP);
        __hip_atomic_fetch_add(op + 32 + dd, o1[rg], __ATOMIC_RELAXED, __HIP_MEMORY_SCOPE_WORKGROUP); }
    __hip_atomic_fetch_add(Lacc + rho, lsum, __ATOMIC_RELAXED, __HIP_MEMORY_SCOPE_WORKGROUP);
}
__device__ __forceinline__ void attn_phase(Frame& F, const Args& a) {
    bf16* Qn = (bf16*)(a.ws + WS_Q); const bf16* Kn = (const bf16*)(a.ws + WS_K); const bf16* VT = (const bf16*)(a.ws + WS_VT); const bf16* SZ = (const bf16*)(a.ws + WS_SZ);
    const bf16* UB = (const bf16*)a.out; const float* cw = a.in[6]; const float* wq = a.in[7]; const float* wk = a.in[8];
    LAS float* Oacc = (LAS float*)F.lds; LAS float* Lacc = Oacc + 512 * 65;
    float mw = 0.f;
    for (int d = 0; d < 64; ++d) mw = fmaxf(mw, fabsf(wq[d] * wk[d]));
    const float shift = 64.f * mw * QSCALE * 1.02f + 0.5f;
    for (int unit = F.vcu; unit < 256; unit += F.G) {
        const int b = unit >> 7, j = (unit >> 4) & 7, tb = unit & 15, T0 = tb * 512;
        for (int i = F.tid; i < 512 * 65 + 512; i += NWAVES * 64) Oacc[i] = 0.f;
        __syncthreads();
        for (int it = 0; it < 6; ++it) attn_tile(Oacc, Lacc, Qn, Kn, VT, b, j, T0, F.wave + 8 * it, F.lane, shift);
        __syncthreads();
        { const int c = F.tid & 7;
#pragma unroll 2
          for (int ps = 0; ps < 8; ++ps) { const int tok = (F.tid >> 3) + 64 * ps, rho = rho512(tok); const size_t row = (size_t)(b * SEQ + T0 + tok);
              const float il = __builtin_amdgcn_rcpf(Lacc[rho]); const LAS float* op = Oacc + rho * 65 + 8 * c;
              f32x4 z0, z1; pg8::unpack8(*(const GAS u32x4*)(SZ + row * 512 + j * 64 + 8 * c), z0, z1);
              f32x4 y0, y1;
#pragma unroll
              for (int i = 0; i < 4; ++i) { y0[i] = op[i] * il * z0[i]; y1[i] = op[4 + i] * il * z1[i]; }
              *(GAS u32x4*)(Qn + row * QKV + j * 64 + 8 * c) = pg8::pack8(y0, y1); } }
        { const int c = F.tid & 7, which = (F.tid >> 3) & 1, ch0 = which * 512 + 64 * j + 8 * c;
          f32x4 w0a = *(const f32x4*)(cw + ch0), w0b = *(const f32x4*)(cw + ch0 + 4), w1a = *(const f32x4*)(cw + 1024 + ch0), w1b = *(const f32x4*)(cw + 1024 + ch0 + 4), w2a = *(const f32x4*)(cw + 2048 + ch0), w2b = *(const f32x4*)(cw + 2048 + ch0 + 4);
#pragma unroll 2
          for (int ps = 0; ps < 16; ++ps) { const int tok = (F.tid >> 4) + 32 * ps, t = T0 + tok; const size_t row = (size_t)(b * SEQ + t); const bf16* ub = UB + row * 2048 + (ch0 >> 2) * 8;
              f32x4 u0a, bza, u0b, bzb, u1a = {}, u1b = {}, u2a = {}, u2b = {}, dmy;
              pg8::unpack8(*(const GAS u32x4*)(ub), u0a, bza); pg8::unpack8(*(const GAS u32x4*)(ub + 8), u0b, bzb);
              if (t >= 1) { pg8::unpack8(*(const GAS u32x4*)(ub - 2048), u1a, dmy); pg8::unpack8(*(const GAS u32x4*)(ub - 2048 + 8), u1b, dmy); }
              if (t >= 2) { pg8::unpack8(*(const GAS u32x4*)(ub - 4096), u2a, dmy); pg8::unpack8(*(const GAS u32x4*)(ub - 4096 + 8), u2b, dmy); }
              const f32x4 ya = bza * (w0a * u2a + w1a * u1a + w2a * u0a), yb = bzb * (w0b * u2b + w1b * u1b + w2b * u0b);
              *(GAS u32x4*)(Qn + row * QKV + 512 + ch0) = pg8::pack8(ya, yb); } }
        __syncthreads();
    }
}

enum { PH_P0A = 0, PH_P0B, PH_G1, PH_ATT, PH_G2, PH_G3, PH_N };
__global__ void __launch_bounds__(NWAVES * 64, 2) mk_fwd(Args args) {
    extern __shared__ __attribute__((aligned(16))) unsigned char lds_raw[];
    Frame F;
    F.lds = (LAS unsigned char*)lds_raw; F.MISC = (volatile LAS unsigned*)(F.lds + MISC_OFF);
    F.tid = threadIdx.x; F.lane = F.tid & 63; F.wave = __builtin_amdgcn_readfirstlane(F.tid >> 6);
    F.G = gridDim.x; { const int bx = blockIdx.x; F.vcu = (F.G % 8 == 0) ? (bx % 8) * (F.G / 8) + bx / 8 : bx; }
    F.ctl = (gu32*)(args.ws + WS_CTL);
    for (int u = F.tid; u < (LDS_BYTES - LDSCTL_OFF) / 4; u += NWAVES * 64) ((LAS unsigned*)(F.lds + LDSCTL_OFF))[u] = 0u;
    __syncthreads();
    const int lo = args.ph_lo, hi = args.ph_hi;
    XcdBarrier bar; bar.bar = (unsigned*)(F.ctl + CW_BAR) + args.li * XCD_BAR_WORDS; bar.x = 0; bar.st = nullptr;
    if (hi - lo > 1) bar = xcd_barrier_post((unsigned*)(F.ctl + CW_BAR) + args.li * XCD_BAR_WORDS, F.MISC + 8);
#define IN(k) (lo <= (k) && (k) < hi)
#define SEAM(k) do { if (IN(k) && IN((k) + 1)) xcd_barrier(bar); } while (0)
    unsigned char* ws = args.ws;
#ifndef NO_P0
    if (IN(PH_P0A)) { p0a(F, args); SEAM(PH_P0A); }
    if (IN(PH_P0B)) { p0b(F, args); SEAM(PH_P0B); }
#endif
#ifndef NO_G1
    if (IN(PH_G1)) {
        pg8::SchedG1 S{(const char*)(ws + WS_XN), (const char*)(ws + WS_WALL), F.G, (int)blockIdx.x};
        pg8::EpiG1 E{(bf16*)args.out, (bf16*)(ws + WS_Q), (bf16*)(ws + WS_K), (bf16*)(ws + WS_VT), (bf16*)(ws + WS_SZ), args.in[7], args.in[8]};
        pg8::gemm_phase(F.lds, S, E); SEAM(PH_G1);
    }
#endif
#ifndef NO_ATT
    if (IN(PH_ATT)) { attn_phase(F, args); SEAM(PH_ATT); }
#endif
#ifndef NO_G2
    if (IN(PH_G2)) {
        pg8::SchedG2 S{(const char*)(ws + WS_XN), (const char*)(ws + WS_WALL), (const char*)(ws + WS_Q), (const char*)(ws + WS_PT), F.G, (int)blockIdx.x};
        pg8::EpiG2 E{(bf16*)(ws + WS_SA), (bf16*)(ws + WS_SB), (bf16*)(ws + WS_MG), args.out};
        pg8::gemm_phase(F.lds, S, E); SEAM(PH_G2);
    }
#endif
#ifndef NO_G3
    if (IN(PH_G3)) {
        pg8::SchedG3 S{(const char*)(ws + WS_MG), (const char*)(ws + WS_WOUT), F.G, (int)blockIdx.x};
        pg8::EpiG3 E{args.in[0], args.out, (const float*)(ws + WS_MODG)};
        pg8::gemm_phase(F.lds, S, E);
    }
#endif
#undef IN
#undef SEAM
}
static int g_grid = 0;
extern "C" void kernel_launch(void* const* d_in, const int* in_sizes, int n_in, void* d_out, int out_size, void* d_ws, size_t ws_size, hipStream_t stream) {
    if (g_grid == 0) {
        int dev = 0, cus = 0;
        (void)hipGetDevice(&dev); (void)hipDeviceGetAttribute(&cus, hipDeviceAttributeMultiprocessorCount, dev);
        (void)hipFuncSetAttribute((const void*)mk_fwd, hipFuncAttributeMaxDynamicSharedMemorySize, LDS_BYTES);
        (void)hipGetLastError();
        g_grid = cus > 0 ? cus : 256;
    }
    unsigned char* ws = (unsigned char*)d_ws;
    (void)hipMemsetAsync(ws + WS_CTL, 0, 64 * 1024, stream);
    Args a{}; for (int i = 0; i < 12; ++i) a.in[i] = (const float*)d_in[i]; a.out = (float*)d_out; a.ws = ws; a.ph_lo = 0; a.ph_hi = PH_N; a.li = 0; a.pad = 0;
    hipLaunchKernelGGL(mk_fwd, dim3(g_grid), dim3(NWAVES * 64), LDS_BYTES, stream, a);
}
```

```cpp
#include <hip/hip_runtime.h>
#include <cstdint>
#include <cstdio>

typedef unsigned short bf16;
constexpr int BATCH = 2, SEQ = 8192, DM = 1024, M = BATCH * SEQ, NIN = 11264;
constexpr int OFF_B = 0, OFF_C = 1024, OFF_X = 2048, OFF_Z = 3072, OFF_Q = 4096, OFF_K = 5632, OFF_V = 7168, OFF_ZB = 8704, OFF_GA = 9216, OFF_GB = 10240;
constexpr int QKV = 1536;
constexpr float QSCALE = 0.125f * 1.4426950408889634f;
constexpr float EPS = 1e-6f;
constexpr size_t MiB = 1u << 20;
constexpr size_t WS_CTL = 0, WS_MOD = 512 * 1024;
constexpr size_t WS_XN = 28 * MiB, WS_Q = 60 * MiB, WS_K = 108 * MiB, WS_VT = 156 * MiB, WS_SZ = 204 * MiB, WS_S1 = 220 * MiB, WS_S2 = 236 * MiB;
constexpr size_t WS_SA = 108 * MiB, WS_SB = 140 * MiB, WS_MG = 172 * MiB;

__host__ __device__ __forceinline__ unsigned f2bf(float f) { unsigned u = __builtin_bit_cast(unsigned, f); return (u + 0x7fffu + ((u >> 16) & 1u)) >> 16; }
__host__ __device__ __forceinline__ float bf2f(unsigned h) { return __builtin_bit_cast(float, (h & 0xffffu) << 16); }
__host__ __device__ __forceinline__ float bfr(float f) { return bf2f(f2bf(f)); }
__host__ __device__ __forceinline__ int sigma16(int x) { return (x & 3) | ((x & 4) << 1) | ((x & 8) >> 1); }
__host__ __device__ __forceinline__ int vt_pos(int g, int t) { const int sh = 2 * g, r = t & ((1 << sh) - 1), l = t >> sh, L = SEQ >> sh; return r * L + (l & ~15) + sigma16(l & 15); }
__device__ __forceinline__ float silu_f(float v) { return v / (1.f + __expf(-v)); }
__device__ __forceinline__ float sigm_f(float v) { return 1.f / (1.f + __expf(-v)); }


#define LAS __attribute__((address_space(3)))
#define GAS __attribute__((address_space(1)))
typedef short bf16x8 __attribute__((ext_vector_type(8)));
typedef float f32x4 __attribute__((ext_vector_type(4)));
typedef float f32x16 __attribute__((ext_vector_type(16)));
typedef unsigned u32x4 __attribute__((ext_vector_type(4)));
typedef unsigned u32x2 __attribute__((ext_vector_type(2)));
typedef GAS unsigned gu32;
#define RLX_AGENT __ATOMIC_RELAXED, __HIP_MEMORY_SCOPE_AGENT
#define LDS_WAIT() asm volatile("s_waitcnt lgkmcnt(0)" ::: "memory")
#define VM_WAIT() asm volatile("s_waitcnt vmcnt(0)" ::: "memory")

#ifndef MIDFLAG
#define MIDFLAG true
#endif
#ifndef CHAINFLAG
#define CHAINFLAG true
#endif
constexpr int NWAVES = 8;
constexpr size_t WS_MODP = 256 * 1024;
constexpr size_t WS_MODG = 768 * 1024;
constexpr size_t WS_WALL = 1 * MiB;
constexpr size_t WS_PT = 23 * MiB;
constexpr size_t WS_WOUT = 26 * MiB;
constexpr size_t WS_YA = 220 * MiB;
constexpr int ROW_WV = 7680, ROW_WG = 9216;
constexpr int CW_BAR = 4096;
constexpr int RING_BYTES = 131072, ATT_OACC_BYTES = 512 * 65 * 4, ATT_BYTES = ATT_OACC_BYTES + 2048;
constexpr int LDSCTL_OFF = 136192, MISC_OFF = LDSCTL_OFF + 320, LDS_BYTES = 147456;
static_assert(ATT_BYTES <= LDSCTL_OFF && MISC_OFF + 128 <= LDS_BYTES, "LDS map");

__device__ __forceinline__ unsigned cvt_pk_bf16(float lo, float hi) { unsigned r; asm volatile("v_cvt_pk_bf16_f32 %0, %1, %2" : "=v"(r) : "v"(lo), "v"(hi)); return r; }
__device__ __forceinline__ float fast_sigmoid(float v) { return __builtin_amdgcn_rcpf(1.f + __builtin_amdgcn_exp2f(-1.4426950408889634f * v)); }
__device__ __forceinline__ int tau256(int c) { return (c & ~15) + sigma16(c & 15); }
__device__ __forceinline__ int dst_win(int n) {
    if (n < 4096) { const int q = n >> 10, ch = n & 1023, tile = ch >> 6, cl = ch & 63, wc = cl >> 4, fq = (cl >> 2) & 3, i3 = cl & 3, bj = q >> 1, nn = q & 1; return 256 * tile + tau256(128 * bj + 32 * wc + 8 * fq + 4 * nn + i3); }
    if (n < 5632) { const int e = n - 4096, h = e >> 6, dd = e & 63; return 256 * (16 + (h >> 2)) + tau256(128 * (dd >> 5) + 32 * (h & 3) + (dd & 31)); }
    if (n < 7168) { const int e = n - 5632, h = e >> 6, dd = e & 63; return 256 * (22 + (h >> 2)) + tau256(128 * (dd >> 5) + 32 * (h & 3) + (dd & 31)); }
    if (n < 8704) return ROW_WV + (n - 7168);
    if (n < 9216) { const int e = n - 8704; return 256 * (28 + (e >> 8)) + tau256(e & 255); }
    const int e = n - 9216; return ROW_WG + (e & ~255) + tau256(e & 255);
}

#define XB_TMO      128
#define XB_XCNT(j)  (256  + 64 * (j))
#define XB_XSUB(j)  (1280 + 64 * (j))
#define XB_XGEN(j)  (2304 + 64 * (j))
#define XB_TOP      3328
#define XB_TOPGEN   3392
#define XCD_BAR_WORDS 3456
#define XB_SPIN_CAP (1u << 18)
__device__ __forceinline__ unsigned xb_ld(unsigned* p)              { return __hip_atomic_load(p, __ATOMIC_RELAXED, __HIP_MEMORY_SCOPE_AGENT); }
__device__ __forceinline__ unsigned xb_add(unsigned* p, unsigned v) { return __hip_atomic_fetch_add(p, v, __ATOMIC_RELAXED, __HIP_MEMORY_SCOPE_AGENT); }
__device__ __forceinline__ unsigned xb_xcc_id() { return (unsigned)__builtin_amdgcn_s_getreg((3 << 11) | 20) & 0xFu; }
#define XB_SPIN(cond, bar) do { unsigned _sp = 0; while (cond) { __builtin_amdgcn_s_sleep(1); \
    if ((++_sp & 255u) == 0u) { if (xb_ld(&(bar)[XB_TMO])) break; if (_sp > XB_SPIN_CAP) { atomicAdd(&(bar)[XB_TMO], 1u); break; } } } } while (0)
struct XcdBarrier { unsigned* bar; unsigned x; volatile LAS unsigned* st; };
__device__ __forceinline__ XcdBarrier xcd_barrier_post(unsigned* bar, volatile LAS unsigned* st) {
    XcdBarrier b; b.bar = bar; b.x = xb_xcc_id(); b.st = st;
    if (threadIdx.x == 0) (void)xb_add(&bar[XB_XCNT(b.x)], 1u);
    return b;
}
__device__ __forceinline__ void xcd_barrier_complete(unsigned* bar, unsigned x, unsigned& nloc, unsigned& nx) {
    const unsigned G = gridDim.x * gridDim.y * gridDim.z;
    unsigned sum, cnt, mine, sp = 0u;
    for (;;) {
        sum = 0u; cnt = 0u; mine = 0u;
#pragma unroll
        for (unsigned j = 0; j < 16; ++j) { const unsigned c = xb_ld(&bar[XB_XCNT(j)]); sum += c; cnt += (c > 0u) ? 1u : 0u; mine = (j == x) ? c : mine; }
        if (sum == G) break;
        __builtin_amdgcn_s_sleep(1);
        if ((++sp & 255u) == 0u) { if (xb_ld(&bar[XB_TMO])) break; if (sp > XB_SPIN_CAP) { atomicAdd(&bar[XB_TMO], 1u); break; } }
    }
    nloc = mine > 0u ? mine : 1u; nx = cnt > 0u ? cnt : 1u;
}
__device__ __forceinline__ void xcd_barrier(const XcdBarrier& b) {
    asm volatile("s_waitcnt vmcnt(0)" ::: "memory");
    __syncthreads();
    if (threadIdx.x == 0) {
        unsigned* bar = b.bar;
        __builtin_amdgcn_s_waitcnt(0);
        unsigned nloc = b.st[0], nx = b.st[1];
        if (nloc == 0u) { xcd_barrier_complete(bar, b.x, nloc, nx); b.st[0] = nloc; b.st[1] = nx; }
        const unsigned old = xb_add(&bar[XB_XSUB(b.x)], 1u);
        const unsigned gen = old / nloc;
        if (old + 1u == (gen + 1u) * nloc) {
            __builtin_amdgcn_fence(__ATOMIC_RELEASE, "agent");
            asm volatile("s_waitcnt vmcnt(0)" ::: "memory");
            const unsigned og = xb_add(&bar[XB_TOP], 1u);
            const unsigned tg = og / nx;
            if (og + 1u == (tg + 1u) * nx) xb_add(&bar[XB_TOPGEN], 1u);
            else XB_SPIN(xb_ld(&bar[XB_TOPGEN]) == tg, bar);
            __builtin_amdgcn_fence(__ATOMIC_ACQUIRE, "agent");
            xb_add(&bar[XB_XGEN(b.x)], 1u);
            asm volatile("s_waitcnt vmcnt(0)" ::: "memory");
        } else {
            XB_SPIN(xb_ld(&bar[XB_XGEN(b.x)]) == gen, bar);
            __builtin_amdgcn_fence(__ATOMIC_ACQUIRE, "agent");
            asm volatile("s_waitcnt vmcnt(0)" ::: "memory");
        }
    }
    __syncthreads();
}

namespace pg8 {
constexpr int BM = 256, BK = 64, HALF = 128, HTB = HALF * BK * 2, NXCD = 8, WGM = 8;
__host__ __device__ __forceinline__ int lds_byte(int r, int c) { const int st = (r >> 4) * 2 + (c >> 5), rr = r & 15, cc = c & 31, ob = rr * 64 + cc * 2; return st * 1024 + (ob ^ (((ob >> 9) & 1) << 5)); }
__host__ __device__ __forceinline__ void stage_rc(int b, int& R, int& C) { const int st = b / 1024, sb = b % 1024, swz = sb ^ (((sb >> 9) & 1) << 5); R = (st >> 1) * 16 + swz / 64; C = (st & 1) * 32 + (swz % 64) / 2; }
__host__ __device__ __forceinline__ int perm32(int rho) { const int n = rho >> 4, i = rho & 15; return 8 * (i >> 2) + 4 * n + (i & 3); }
__device__ __forceinline__ void tile_of(int L, int nM, int nN, int& pm, int& pn) {
    const int nwg = nM * nN; int wgid = L; { const int q = nwg / NXCD, r = nwg % NXCD, xcd = wgid % NXCD, off = wgid / NXCD; wgid = (xcd < r ? xcd * (q + 1) : r * (q + 1) + (xcd - r) * q) + off; }
    const int nig = WGM * nN, gid = wgid / nig, fm = gid * WGM, gsz = (nM - fm) < WGM ? (nM - fm) : WGM;
    pm = fm + ((wgid % nig) % gsz); pn = (wgid % nig) / gsz;
}
enum { K_CONV = 0, K_Q, K_K, K_ZB, K_V, K_GA, K_GB, K_MB, K_MERGE, K_OUT };
struct UnitD { const char* A; const char* B; unsigned pA, pB; int nt, kind, pm, pn; };

template <class Epi, class Sched>
__device__ __forceinline__ void gemm_phase(LAS unsigned char* lds, const Sched& S, const Epi& E) {
    const int tid = threadIdx.x, wid = __builtin_amdgcn_readfirstlane(tid >> 6), lane = tid & 63, wr = wid >> 2, wc = wid & 3, fr = lane & 15, fq = lane >> 4;
    unsigned rowA[2], rowB[2], col2[2];
#pragma unroll
    for (int i = 0; i < 2; ++i) { int R, C; stage_rc(tid * 16 + i * 8192, R, C); const int Rb = (R & ~31) + perm32(R & 31);
        rowA[i] = (unsigned)R; rowB[i] = (unsigned)tau256(Rb); col2[i] = (unsigned)C * 2u; }
    const size_t kstep = (size_t)(BK * 2);
    const unsigned ldsw = (unsigned)wid * 1024u;
    const int aoff = lds_byte(wr * 64 + fr, fq * 8), boff = lds_byte(wc * 32 + fr, fq * 8);
#define PG8_SA(b, h) (((b) * 2 + (h)) * HTB)
#define PG8_SB(b, h) ((4 + (b) * 2 + (h)) * HTB)
#define PG8_STAGE(bufoff, gbase, rowv, pitch) do { _Pragma("unroll") for (int _i = 0; _i < 2; ++_i) \
        __builtin_amdgcn_global_load_lds((const unsigned*)((const char*)(gbase) + (rowv[_i] * (pitch) + col2[_i])), (LAS unsigned*)(lds + (bufoff) + ldsw + _i * 8192), 16, 0, 0); } while (0)
#define PG8_LDA(dst, b, h) do { _Pragma("unroll") for (int m = 0; m < 4; ++m) _Pragma("unroll") for (int k = 0; k < 2; ++k) dst[m][k] = *(const LAS bf16x8*)(lds + PG8_SA(b, h) + aoff + m * 2048 + k * 1024); } while (0)
#define PG8_LDB(dst, b, h) do { _Pragma("unroll") for (int n = 0; n < 2; ++n) _Pragma("unroll") for (int k = 0; k < 2; ++k) dst[n][k] = *(const LAS bf16x8*)(lds + PG8_SB(b, h) + boff + n * 2048 + k * 1024); } while (0)
#define PG8_MMA(ai, bj, At, Bt) do { __builtin_amdgcn_s_setprio(1); _Pragma("unroll") for (int m = 0; m < 4; ++m) _Pragma("unroll") for (int n = 0; n < 2; ++n) _Pragma("unroll") for (int k = 0; k < 2; ++k) \
        acc[ai][bj][m][n] = __builtin_amdgcn_mfma_f32_16x16x32_bf16(Bt[n][k], At[m][k], acc[ai][bj][m][n], 0, 0, 0); __builtin_amdgcn_s_setprio(0); } while (0)
#define PG8_WAIT_V(n) asm volatile("s_waitcnt vmcnt(" #n ")" ::: "memory")
#define PG8_WAIT_L(n) asm volatile("s_waitcnt lgkmcnt(" #n ")" ::: "memory")
#define PG8_BAR __builtin_amdgcn_s_barrier()
#define PG8_SCHED __builtin_amdgcn_sched_barrier(0)
    UnitD cur, nxt; int ui = 0;
    if (!S.next(0, cur)) return;
    f32x4 acc[2][2][4][2];
#pragma unroll
    for (int a = 0; a < 2; ++a)
#pragma unroll
        for (int b = 0; b < 2; ++b)
#pragma unroll
            for (int m = 0; m < 4; ++m)
#pragma unroll
                for (int n = 0; n < 2; ++n) acc[a][b][m][n] = (f32x4){0.f, 0.f, 0.f, 0.f};
    bf16x8 At[4][2], B0[2][2], B1[2][2];
    const char* cA = cur.A; const char* cB = cur.B;
    {   const unsigned pA = cur.pA, pB = cur.pB; const size_t hA = (size_t)HALF * pA, hB = (size_t)HALF * pB;
        PG8_STAGE(PG8_SB(0, 0), cB, rowB, pB); PG8_STAGE(PG8_SB(0, 1), cB + hB, rowB, pB); PG8_STAGE(PG8_SA(0, 0), cA, rowA, pA); PG8_STAGE(PG8_SA(0, 1), cA + hA, rowA, pA);
        if (wr == 1) PG8_BAR;
        PG8_WAIT_V(2); PG8_BAR;
        PG8_STAGE(PG8_SB(1, 0), cB + kstep, rowB, pB); PG8_STAGE(PG8_SA(1, 0), cA + kstep, rowA, pA); PG8_STAGE(PG8_SB(1, 1), cB + hB + kstep, rowB, pB);
        PG8_WAIT_V(6); PG8_BAR;
    }
    for (;;) {
        const bool has_next = S.next(ui + 1, nxt);
        const char* nA = has_next ? nxt.A : cA; const char* nB = has_next ? nxt.B : cB;
        const unsigned npA = has_next ? nxt.pA : cur.pA, npB = has_next ? nxt.pB : cur.pB;
        const unsigned pA = cur.pA; const size_t hA = (size_t)HALF * pA;
        const int nt = cur.nt;
        for (int t = 0; t < nt; t += 2) {
            const bool last = (t == nt - 2);
            const char* a1 = cA + (size_t)(t + 1) * kstep;
            const char* a2 = last ? nA : cA + (size_t)(t + 2) * kstep; const char* b2 = last ? nB : cB + (size_t)(t + 2) * kstep;
            const unsigned p2A = last ? npA : pA, p2B = last ? npB : cur.pB; const size_t h2A = (size_t)HALF * p2A, h2B = (size_t)HALF * p2B;
            const char* a3 = a2 + kstep; const char* b3 = b2 + kstep;
            PG8_LDB(B0, 0, 0); PG8_LDB(B1, 0, 1); PG8_SCHED; PG8_LDA(At, 0, 0); PG8_STAGE(PG8_SA(1, 1), a1 + hA, rowA, pA);
            PG8_WAIT_V(8); PG8_WAIT_L(0); PG8_BAR; PG8_MMA(0, 0, At, B0); PG8_MMA(0, 1, At, B1); PG8_BAR; PG8_SCHED;
            PG8_LDA(At, 0, 1); PG8_STAGE(PG8_SB(0, 0), b2, rowB, p2B); PG8_STAGE(PG8_SB(0, 1), b2 + h2B, rowB, p2B); PG8_STAGE(PG8_SA(0, 0), a2, rowA, p2A);
            PG8_WAIT_V(8); PG8_WAIT_L(0); PG8_BAR; PG8_MMA(1, 0, At, B0); PG8_MMA(1, 1, At, B1); PG8_BAR; PG8_SCHED;
            PG8_LDB(B0, 1, 0); PG8_LDB(B1, 1, 1); PG8_SCHED; PG8_LDA(At, 1, 0); PG8_STAGE(PG8_SA(0, 1), a2 + h2A, rowA, p2A);
            PG8_WAIT_V(8); PG8_WAIT_L(0); PG8_BAR; PG8_MMA(0, 0, At, B0); PG8_MMA(0, 1, At, B1); PG8_BAR; PG8_SCHED;
            PG8_LDA(At, 1, 1); PG8_STAGE(PG8_SB(1, 0), b3, rowB, p2B); PG8_STAGE(PG8_SB(1, 1), b3 + h2B, rowB, p2B); PG8_STAGE(PG8_SA(1, 0), a3, rowA, p2A);
            PG8_WAIT_V(8); PG8_WAIT_L(0); PG8_BAR; PG8_MMA(1, 0, At, B0); PG8_MMA(1, 1, At, B1); PG8_BAR; PG8_SCHED;
        }
        if (wr == 0) PG8_BAR;
        if (Epi::HAS_CHAIN && cur.kind == K_MB) { E.rescale(acc, cur, wr, wc, fr, fq); }
        else {
        E(acc, cur, wr, wc, fr, fq);
        if (!has_next) break;
#pragma unroll
        for (int a = 0; a < 2; ++a)
#pragma unroll
            for (int b = 0; b < 2; ++b)
#pragma unroll
                for (int m = 0; m < 4; ++m)
#pragma unroll
                    for (int n = 0; n < 2; ++n) acc[a][b][m][n] = (f32x4){0.f, 0.f, 0.f, 0.f};
        }
        cur = nxt; cA = nA; cB = nB; ++ui;
        if (wr == 1) PG8_BAR;
    }
    PG8_WAIT_V(0);
    PG8_BAR;
#undef PG8_SA
#undef PG8_SB
#undef PG8_STAGE
#undef PG8_LDA
#undef PG8_LDB
#undef PG8_MMA
#undef PG8_WAIT_V
#undef PG8_WAIT_L
#undef PG8_BAR
#undef PG8_SCHED
}

__device__ __forceinline__ u32x4 pack8(const f32x4 a, const f32x4 b) { u32x4 w; w.x = cvt_pk_bf16(a[0], a[1]); w.y = cvt_pk_bf16(a[2], a[3]); w.z = cvt_pk_bf16(b[0], b[1]); w.w = cvt_pk_bf16(b[2], b[3]); return w; }
__device__ __forceinline__ void unpack8(const u32x4 w, f32x4& a, f32x4& b) {
    a[0] = __uint_as_float(w.x << 16); a[1] = __uint_as_float(w.x & 0xffff0000u); a[2] = __uint_as_float(w.y << 16); a[3] = __uint_as_float(w.y & 0xffff0000u);
    b[0] = __uint_as_float(w.z << 16); b[1] = __uint_as_float(w.z & 0xffff0000u); b[2] = __uint_as_float(w.w << 16); b[3] = __uint_as_float(w.w & 0xffff0000u); }

#define LD16(base, off) (*(const u32x4*)((const char*)(base) + (unsigned)(off)))
#define ST16(base, off, v) (*(u32x4*)((char*)(base) + (unsigned)(off)) = (v))
struct EpiG1 {
    static constexpr bool HAS_CHAIN = false;
    __device__ __forceinline__ void rescale(f32x4 (&)[2][2][4][2], const UnitD&, int, int, int, int) const {}
    bf16* UB; bf16* Qn; bf16* Kn; bf16* VT; bf16* SZ; const float* wq; const float* wk;
    __device__ __forceinline__ void operator()(f32x4 (&acc)[2][2][4][2], const UnitD& u, int wr, int wc, int fr, int fq) const {
        const unsigned row0 = (unsigned)(u.pm * BM + wr * 64 + fr);
        if (u.kind == K_CONV) {
            const unsigned o0 = row0 * 4096u + (unsigned)(16 * u.pn + 4 * wc + fq) * 16u;
#pragma unroll
            for (int ai = 0; ai < 2; ++ai)
#pragma unroll
                for (int m = 0; m < 4; ++m) { const f32x4 b = acc[ai][0][m][0], c = acc[ai][0][m][1], x = acc[ai][1][m][0], z = acc[ai][1][m][1]; f32x4 uu = c * x, bz;
#pragma unroll
                    for (int i = 0; i < 4; ++i) bz[i] = b[i] * z[i] * fast_sigmoid(z[i]);
                    ST16(UB, o0 + (unsigned)(ai * HALF + m * 16) * 4096u, pack8(uu, bz)); }
        } else if (u.kind == K_Q || u.kind == K_K) {
            const bool isq = (u.kind == K_Q); const float* w = isq ? wq : wk; const float sc = isq ? QSCALE : 1.0f; bf16* dst = isq ? Qn : Kn;
            const int head = 4 * u.pn + wc, sh = 2 * (u.pn >> 1), bb = u.pm >> 5, tbase = (u.pm & 31) * 256 + wr * 64 + fr;
            const unsigned o0 = ((unsigned)(bb * 24 + head) << 20) + ((unsigned)fq << 9);
            f32x4 wv[2][2];
#pragma unroll
            for (int bj = 0; bj < 2; ++bj)
#pragma unroll
                for (int n = 0; n < 2; ++n) wv[bj][n] = *(const f32x4*)(w + 32 * bj + 8 * fq + 4 * n);
#pragma unroll
            for (int ai = 0; ai < 2; ++ai)
#pragma unroll
                for (int m = 0; m < 4; ++m) { float ss = 0.f;
#pragma unroll
                    for (int bj = 0; bj < 2; ++bj)
#pragma unroll
                        for (int n = 0; n < 2; ++n) { const f32x4 v = acc[ai][bj][m][n]; ss += (v[0] * v[0] + v[1] * v[1]) + (v[2] * v[2] + v[3] * v[3]); }
                    ss += __shfl_xor(ss, 16); ss += __shfl_xor(ss, 32);
                    const float r = __builtin_amdgcn_rsqf(ss * (1.f / 64.f) + EPS) * sc;
                    const int t = tbase + ai * HALF + m * 16, pos = (t & ((1 << sh) - 1)) * (SEQ >> sh) + (t >> sh); const unsigned o = o0 + ((unsigned)pos << 7 & ~4095u) + ((unsigned)(pos & 31) << 4);
#pragma unroll
                    for (int bj = 0; bj < 2; ++bj) ST16(dst, o + 2048u * bj, pack8(acc[ai][bj][m][0] * r * wv[bj][0], acc[ai][bj][m][1] * r * wv[bj][1])); }
        } else if (u.kind == K_ZB) {
            const unsigned o0 = row0 * 1024u + (unsigned)(256 * u.pn + 32 * wc + 8 * fq) * 2u;
#pragma unroll
            for (int ai = 0; ai < 2; ++ai)
#pragma unroll
                for (int m = 0; m < 4; ++m)
#pragma unroll
                    for (int bj = 0; bj < 2; ++bj) { f32x4 v0 = acc[ai][bj][m][0], v1 = acc[ai][bj][m][1];
#pragma unroll
                        for (int i = 0; i < 4; ++i) { v0[i] = v0[i] * fast_sigmoid(v0[i]); v1[i] = v1[i] * fast_sigmoid(v1[i]); }
                        ST16(SZ, o0 + (unsigned)(ai * HALF + m * 16) * 1024u + 256u * bj, pack8(v0, v1)); }
        } else {
            const int bb = u.pn >> 5, blk0 = 8 * (u.pn & 31) + wc;
#pragma unroll
            for (int ai = 0; ai < 2; ++ai) { const unsigned oh = ((unsigned)(bb * 24 + 4 * u.pm + 2 * ai + wr) << 20) + ((unsigned)blk0 << 12) + ((unsigned)fq << 9) + ((unsigned)fr << 4);
#pragma unroll
                for (int m = 0; m < 4; ++m)
#pragma unroll
                    for (int bj = 0; bj < 2; ++bj) ST16(VT, oh + (unsigned)(4 * bj << 12) + (unsigned)((4 * (m >> 1)) << 9) + (unsigned)((16 * (m & 1)) << 4), pack8(acc[ai][bj][m][0], acc[ai][bj][m][1])); }
        }
    }
};
struct EpiG2 {
    static constexpr bool HAS_CHAIN = false;
    bf16* SA; bf16* SB; bf16* MG; float* T;
    __device__ __forceinline__ void rescale(f32x4 (&)[2][2][4][2], const UnitD&, int, int, int, int) const {}
    __device__ __forceinline__ void operator()(f32x4 (&acc)[2][2][4][2], const UnitD& u, int wr, int wc, int fr, int fq) const {
        const unsigned o0 = (unsigned)(u.pm * BM + wr * 64 + fr) * 2048u + (unsigned)(256 * u.pn + 32 * wc + 8 * fq) * 2u;
        if (u.kind == K_MB) {
#pragma unroll
            for (int ai = 0; ai < 2; ++ai)
#pragma unroll
                for (int m = 0; m < 4; ++m)
#pragma unroll
                    for (int bj = 0; bj < 2; ++bj) { const unsigned o = o0 + (unsigned)(ai * HALF + m * 16) * 2048u + 256u * bj; f32x4 b0, b1; unpack8(LD16(SB, o), b0, b1);
                        *(f32x4*)((char*)T + 2u * o) = acc[ai][bj][m][0] * b0; *(f32x4*)((char*)T + 2u * o + 16u) = acc[ai][bj][m][1] * b1; if (bj == 1) asm volatile("" ::: "memory"); }
        } else if (u.kind == K_MERGE) {
#pragma unroll
            for (int ai = 0; ai < 2; ++ai)
#pragma unroll
                for (int m = 0; m < 4; ++m)
#pragma unroll
                    for (int bj = 0; bj < 2; ++bj) { const unsigned o = o0 + (unsigned)(ai * HALF + m * 16) * 2048u + 256u * bj; f32x4 a0, a1; unpack8(LD16(SA, o), a0, a1);
                        const f32x4 t0 = *(const f32x4*)((const char*)T + 2u * o), t1 = *(const f32x4*)((const char*)T + 2u * o + 16u);
                        ST16(MG, o, pack8(acc[ai][bj][m][0] * a0 + t0, acc[ai][bj][m][1] * a1 + t1)); if (bj == 1) asm volatile("" ::: "memory"); }
        } else {
            const bool isa = (u.kind == K_GA); bf16* dst = isa ? SA : SB; const float lo = 0.f;
#pragma unroll
            for (int ai = 0; ai < 2; ++ai)
#pragma unroll
                for (int m = 0; m < 4; ++m)
#pragma unroll
                    for (int bj = 0; bj < 2; ++bj) { f32x4 v0 = acc[ai][bj][m][0], v1 = acc[ai][bj][m][1];
#pragma unroll
                        for (int i = 0; i < 4; ++i) { v0[i] = fmaxf(fast_sigmoid(v0[i]), lo); v1[i] = fmaxf(fast_sigmoid(v1[i]), lo); }
                        ST16(dst, o0 + (unsigned)(ai * HALF + m * 16) * 2048u + 256u * bj, pack8(v0, v1)); }
        }
    }
};
struct EpiG3 {
    static constexpr bool HAS_CHAIN = false;
    __device__ __forceinline__ void rescale(f32x4 (&)[2][2][4][2], const UnitD&, int, int, int, int) const {}
    const float* x; float* out; const float* gate;
    __device__ __forceinline__ void operator()(f32x4 (&acc)[2][2][4][2], const UnitD& u, int wr, int wc, int fr, int fq) const {
        const int col0 = 256 * u.pn + 32 * wc + 8 * fq; const float* gp = gate + (u.pm >> 5) * DM + col0;
        f32x4 gv[2][2];
#pragma unroll
        for (int bj = 0; bj < 2; ++bj)
#pragma unroll
            for (int n = 0; n < 2; ++n) gv[bj][n] = *(const f32x4*)(gp + bj * HALF + 4 * n);
        const unsigned o0 = (unsigned)(u.pm * BM + wr * 64 + fr) * 4096u + (unsigned)col0 * 4u;
#pragma unroll
        for (int ai = 0; ai < 2; ++ai)
#pragma unroll
            for (int m = 0; m < 4; ++m) {
#pragma unroll
                for (int bj = 0; bj < 2; ++bj)
#pragma unroll
                    for (int n = 0; n < 2; ++n) { const unsigned o = o0 + (unsigned)(ai * HALF + m * 16) * 4096u + 512u * bj + 16u * n;
                        *(f32x4*)((char*)out + o) = *(const f32x4*)((const char*)x + o) + gv[bj][n] * acc[ai][bj][m][n]; }
                if (m & 1) asm volatile("" ::: "memory"); }
    }
};
struct SchedG1 {
    const char* XN; const char* WALL; int G, c;
    __device__ __forceinline__ bool next(int i, UnitD& u) const {
        const int L = i * G + c; if (L >= 2304) return false;
        if (L < 1920) { int pm, pn; tile_of(L, 64, 30, pm, pn); u.A = XN + (size_t)pm * (256 * 2048); u.B = WALL + (size_t)pn * (256 * 2048); u.pA = 2048u; u.pB = 2048u; u.nt = 16; u.pm = pm;
            if (pn < 16) { u.kind = K_CONV; u.pn = pn; } else if (pn < 22) { u.kind = K_Q; u.pn = pn - 16; } else if (pn < 28) { u.kind = K_K; u.pn = pn - 22; } else { u.kind = K_ZB; u.pn = pn - 28; }
        } else { int pm, pn; tile_of(L - 1920, 6, 64, pm, pn); const int sh = 2 * (pm >> 1), b = pn >> 5, q = pn & 31, tpr = 32 >> sh, r = q / tpr, l0 = 256 * (q % tpr);
            u.A = WALL + (size_t)(ROW_WV + 256 * pm) * 2048; u.B = XN + (size_t)(b * SEQ + (l0 << sh) + r) * 2048; u.pA = 2048u; u.pB = 2048u << sh; u.nt = 16; u.kind = K_V; u.pm = pm; u.pn = pn; }
        return true;
    }
};
struct SchedG2 {
    const char* XN; const char* WALL; const char* Y; const char* YA; const char* PT; int G, c;
    __device__ __forceinline__ bool next(int i, UnitD& u) const {
        const int j = i >> 2, sub = i & 3, L = j * G + c; if (L >= 256) return false;
        int pm, pn; tile_of(L, 64, 4, pm, pn); u.pm = pm; u.pn = pn;
        if (sub < 2) { u.A = XN + (size_t)pm * (256 * 2048); u.B = WALL + (size_t)(ROW_WG + 1024 * sub + 256 * pn) * 2048; u.pA = 2048u; u.pB = 2048u; u.nt = 16; u.kind = sub == 0 ? K_GA : K_GB; }
        else if (sub == 2) { u.A = Y + (size_t)pm * (256 * 1024); u.B = PT + (size_t)pn * (256 * 3072); u.pA = 1024u; u.pB = 3072u; u.nt = 8; u.kind = K_MB; }
        else { u.A = YA + (size_t)pm * (256 * 2048); u.B = PT + (size_t)pn * (256 * 3072) + 1024; u.pA = 2048u; u.pB = 3072u; u.nt = 16; u.kind = K_MERGE; }
        return true;
    }
};
struct SchedG3 {
    const char* MGp; const char* WOUT; int G, c;
    __device__ __forceinline__ bool next(int i, UnitD& u) const {
        const int L = i * G + c; if (L >= 256) return false;
        int pm, pn; tile_of(L, 64, 4, pm, pn); u.pm = pm; u.pn = pn; u.A = MGp + (size_t)pm * (256 * 2048); u.B = WOUT + (size_t)pn * (256 * 2048); u.pA = 2048u; u.pB = 2048u; u.nt = 16; u.kind = K_OUT; return true;
    }
};
}

struct Frame {
    LAS unsigned char* lds; volatile LAS unsigned* MISC; gu32* ctl;
    int tid, lane, wave, vcu, G;
};
struct Args { const float* in[12]; float* out; unsigned char* ws; int ph_lo, ph_hi, li, pad; };

__device__ __forceinline__ float wave_sum(float v) {
#pragma unroll
    for (int o = 1; o < 64; o <<= 1) v += __shfl_xor(v, o);
    return v;
}
template <class RowMap>
__device__ __forceinline__ void p0_transpose_item(const float* W, int N, bf16* WT, int pitch, int koff, LAS float* scr, int k0, int n0, int lane, const RowMap& rm) {
#pragma unroll 8
    for (int i = 0; i < 32; ++i) { const int kk = 2 * i + (lane >> 5); scr[kk * 33 + (lane & 31)] = W[(size_t)(k0 + kk) * N + n0 + (lane & 31)]; }
    LDS_WAIT(); asm volatile("" ::: "memory");
    const int c = lane & 7;
#pragma unroll
    for (int j = 0; j < 4; ++j) { const int n = (lane >> 3) + 8 * j; const LAS float* s = scr + (8 * c) * 33 + n;
        u32x4 o; o.x = cvt_pk_bf16(s[0 * 33], s[1 * 33]); o.y = cvt_pk_bf16(s[2 * 33], s[3 * 33]); o.z = cvt_pk_bf16(s[4 * 33], s[5 * 33]); o.w = cvt_pk_bf16(s[6 * 33], s[7 * 33]);
        *(GAS u32x4*)(WT + (size_t)rm(n0 + n) * pitch + koff + k0 + 8 * c) = o; }
    LDS_WAIT(); asm volatile("" ::: "memory");
}
struct RmWin { __device__ __forceinline__ int operator()(int n) const { return dst_win(n); } };
struct RmTau { __device__ __forceinline__ int operator()(int n) const { return (n & ~255) + tau256(n & 255); } };

__device__ __forceinline__ void p0a(Frame& F, const Args& a) {
    LAS float* scr = (LAS float*)(F.lds + F.wave * 16384);
    const int gw = F.vcu * NWAVES + F.wave, NGW = F.G * NWAVES;
    const float* w_in = a.in[5]; const float* w_brc = a.in[9]; const float* w_bra = a.in[10]; const float* w_out = a.in[11];
    bf16* WALL = (bf16*)(a.ws + WS_WALL); bf16* PT = (bf16*)(a.ws + WS_PT); bf16* WOUT = (bf16*)(a.ws + WS_WOUT);
    constexpr int I_IN = 16 * 352, I_C = 16 * 32, I_A = 8 * 32, I_O = 16 * 32, NITEMS = I_IN + I_C + I_A + I_O;
    { const float* c = a.in[1]; const float* w_ada = a.in[2]; float* modp = (float*)(a.ws + WS_MODP);
      for (int it = gw; it < 768; it += NGW) { const int cch = it % 96, ks = it / 96, col = 32 * cch + (F.lane & 31), kb = ks * 128 + (F.lane >> 5) * 64; float a0 = 0.f, a1 = 0.f;
#pragma unroll 8
          for (int i = 0; i < 64; ++i) { const int k = kb + i; const float w = w_ada[(size_t)k * 3072 + col], c0 = c[k], c1 = c[DM + k]; a0 += c0 * fast_sigmoid(c0) * w; a1 += c1 * fast_sigmoid(c1) * w; }
          a0 += __shfl_xor(a0, 32); a1 += __shfl_xor(a1, 32);
          if (F.lane < 32) { modp[(size_t)(ks * 2 + 0) * 3072 + col] = a0; modp[(size_t)(ks * 2 + 1) * 3072 + col] = a1; } } }
    for (int it = gw; it < NITEMS; it += NGW) {
        int r = it;
        if (r < I_IN) { p0_transpose_item(w_in, NIN, WALL, 1024, 0, scr, 64 * (r / 352), 32 * (r % 352), F.lane, RmWin()); continue; } r -= I_IN;
        if (r < I_C) { p0_transpose_item(w_brc, DM, PT, 1536, 512, scr, 64 * (r / 32), 32 * (r % 32), F.lane, RmTau()); continue; } r -= I_C;
        if (r < I_A) { p0_transpose_item(w_bra, DM, PT, 1536, 0, scr, 64 * (r / 32), 32 * (r % 32), F.lane, RmTau()); continue; } r -= I_A;
        p0_transpose_item(w_out, DM, WOUT, 1024, 0, scr, 64 * (r / 32), 32 * (r % 32), F.lane, RmTau());
    }
}
__device__ __forceinline__ void p0b(Frame& F, const Args& a) {
    const float* x = a.in[0]; const float* b_ada = a.in[3]; const float* norm_w = a.in[4]; const float* modp = (const float*)(a.ws + WS_MODP);
    bf16* XN = (bf16*)(a.ws + WS_XN); float* modg = (float*)(a.ws + WS_MODG);
    LAS float* tg = (LAS float*)F.lds; LAS float* ts = tg + 1024;
    int curb = -1;
    for (int blk = F.vcu; blk < M / 64; blk += F.G) {
        const int b = blk / (SEQ / 64);
        if (b != curb) { __syncthreads();
            for (int k = F.tid; k < 2048; k += NWAVES * 64) { const int col = (k < 1024) ? 1024 + k : k - 1024; float s = b_ada[col];
#pragma unroll
                for (int ks = 0; ks < 8; ++ks) s += modp[(size_t)(ks * 2 + b) * 3072 + col];
                if (k < 1024) tg[k] = norm_w[k] * (1.f + s); else ts[k - 1024] = s; }
            __syncthreads(); curb = b; }
#pragma unroll 2
        for (int i = 0; i < 8; ++i) { const int m = blk * 64 + F.wave * 8 + i; const GAS f32x4* xr = (const GAS f32x4*)(x + (size_t)m * DM) + F.lane;
            f32x4 v[4]; float ss = 0.f;
#pragma unroll
            for (int j = 0; j < 4; ++j) { v[j] = xr[64 * j]; ss += (v[j][0] * v[j][0] + v[j][1] * v[j][1]) + (v[j][2] * v[j][2] + v[j][3] * v[j][3]); }
            const float rstd = __builtin_amdgcn_rsqf(wave_sum(ss) * (1.f / DM) + EPS);
            GAS u32x2* o8 = (GAS u32x2*)(XN + (size_t)m * DM) + F.lane;
#pragma unroll
            for (int j = 0; j < 4; ++j) { const f32x4 g = *(const LAS f32x4*)(tg + 4 * F.lane + 256 * j), s = *(const LAS f32x4*)(ts + 4 * F.lane + 256 * j); const f32x4 h = v[j] * rstd * g + s;
                u32x2 w; w.x = cvt_pk_bf16(h[0], h[1]); w.y = cvt_pk_bf16(h[2], h[3]); o8[64 * j] = w; } }
    }
    if (F.vcu == 0) for (int k = F.tid; k < 2048; k += NWAVES * 64) { const int b = k >> 10, col = 2048 + (k & 1023); float s = b_ada[col];
#pragma unroll
        for (int ks = 0; ks < 8; ++ks) s += modp[(size_t)(ks * 2 + b) * 3072 + col];
        modg[k] = s; }
    __syncthreads();
}

__device__ __forceinline__ int rho512(int t) { return (t & ~31) | ((t ^ (t >> 5)) & 31); }
__device__ __forceinline__ void attn_tile(LAS float* Oacc, LAS float* Lacc, const bf16* Qn, const bf16* Kn, const bf16* VT, int b, int j, int T0, int ti, int lane, float shift) {
    const int g = ti >> 4, tt = ti & 15, sh = 2 * g, r32 = lane & 31, h = lane >> 5;
    int r, lq0;
    if (g == 0) { r = 0; lq0 = T0 + 32 * tt; } else if (g == 1) { r = tt >> 2; lq0 = (T0 >> 2) + 32 * (tt & 3); } else { r = tt; lq0 = T0 >> 4; }
    const int head = g * 8 + j, L = SEQ >> sh;
    const int tq = ((lq0 + r32) << sh) + r;
    const unsigned hb = ((unsigned)(b * 24 + head) << 20) + (unsigned)lane * 16u;
    const int kl0 = lq0 - 128, pos0 = r * L;
    bf16x8 qf[4], kf[5][4], v0f[5][2], v1f[5][2];
    { const char* qp = (const char*)Qn + hb + ((unsigned)((pos0 + lq0) >> 5) << 12);
#pragma unroll
      for (int s = 0; s < 4; ++s) qf[s] = *(const GAS bf16x8*)(qp + 1024 * s); }
#pragma unroll
    for (int kb = 0; kb < 5; ++kb) { const int klb = kl0 + 32 * kb, klc = klb < 0 ? 0 : klb; const char* kp = (const char*)Kn + hb + ((unsigned)((pos0 + klc) >> 5) << 12);
#pragma unroll
        for (int s = 0; s < 4; ++s) kf[kb][s] = *(const GAS bf16x8*)(kp + 1024 * s); }
#pragma unroll
    for (int kb = 0; kb < 5; ++kb) { const int klb = kl0 + 32 * kb, klc = klb < 0 ? 0 : klb; const char* vp = (const char*)VT + hb + ((unsigned)((pos0 + klc) >> 5) << 12);
        v0f[kb][0] = *(const GAS bf16x8*)(vp); v0f[kb][1] = *(const GAS bf16x8*)(vp + 1024); }
    u32x4 pw[5][2]; float lsum = 0.f;
#pragma unroll
    for (int kb = 0; kb < 5; ++kb) {
        f32x16 sacc = {};
#pragma unroll
        for (int s = 0; s < 4; ++s) sacc = __builtin_amdgcn_mfma_f32_32x32x16_bf16(kf[kb][s], qf[s], sacc, 0, 0, 0);
        const bool blk_ok = (kl0 + 32 * kb) >= 0;
        float p[16];
#pragma unroll
        for (int rg = 0; rg < 16; ++rg) { const int kk = (rg & 3) + 8 * (rg >> 2) + 4 * h; float e = __builtin_amdgcn_exp2f(sacc[rg] - shift);
            if (kb == 0) e = (kk >= r32) ? e : 0.f;
            if (kb == 4) e = (kk <= r32) ? e : 0.f;
            if (kb < 4) e = blk_ok ? e : 0.f;
            p[rg] = e; lsum += e; }
        pw[kb][0].x = cvt_pk_bf16(p[0], p[1]); pw[kb][0].y = cvt_pk_bf16(p[2], p[3]); pw[kb][0].z = cvt_pk_bf16(p[4], p[5]); pw[kb][0].w = cvt_pk_bf16(p[6], p[7]);
        pw[kb][1].x = cvt_pk_bf16(p[8], p[9]); pw[kb][1].y = cvt_pk_bf16(p[10], p[11]); pw[kb][1].z = cvt_pk_bf16(p[12], p[13]); pw[kb][1].w = cvt_pk_bf16(p[14], p[15]);
    }
#pragma unroll
    for (int kb = 0; kb < 5; ++kb) { const int klb = kl0 + 32 * kb, klc = klb < 0 ? 0 : klb; const char* vp = (const char*)VT + hb + ((unsigned)((pos0 + klc) >> 5) << 12) + 2048;
        v1f[kb][0] = *(const GAS bf16x8*)(vp); v1f[kb][1] = *(const GAS bf16x8*)(vp + 1024); }
    f32x16 o0 = {}, o1 = {};
#pragma unroll
    for (int kb = 0; kb < 5; ++kb) { o0 = __builtin_amdgcn_mfma_f32_32x32x16_bf16(v0f[kb][0], __builtin_bit_cast(bf16x8, pw[kb][0]), o0, 0, 0, 0); o0 = __builtin_amdgcn_mfma_f32_32x32x16_bf16(v0f[kb][1], __builtin_bit_cast(bf16x8, pw[kb][1]), o0, 0, 0, 0); }
#pragma unroll
    for (int kb = 0; kb < 5; ++kb) { o1 = __builtin_amdgcn_mfma_f32_32x32x16_bf16(v1f[kb][0], __builtin_bit_cast(bf16x8, pw[kb][0]), o1, 0, 0, 0); o1 = __builtin_amdgcn_mfma_f32_32x32x16_bf16(v1f[kb][1], __builtin_bit_cast(bf16x8, pw[kb][1]), o1, 0, 0, 0); }
    const int rho = rho512(tq - T0); LAS float* op = Oacc + rho * 65 + 4 * h;
    lsum += __shfl_xor(lsum, 32);
    if (g == 0) {
#pragma unroll
        for (int rg = 0; rg < 16; ++rg) { const int dd = (rg & 3) + 8 * (rg >> 2); op[dd] = o0[rg]; op[32 + dd] = o1[rg]; }
        if (h == 0) Lacc[rho] = lsum;
    } else {
        float t0[16], t1[16];
#pragma unroll
        for (int rg = 0; rg < 16; ++rg) { const int dd = (rg & 3) + 8 * (rg >> 2); t0[rg] = op[dd]; t1[rg] = op[32 + dd]; }
        const float lo = Lacc[rho];
#pragma unroll
        for (int rg = 0; rg < 16; ++rg) { const int dd = (rg & 3) + 8 * (rg >> 2); op[dd] = t0[rg] + o0[rg]; op[32 + dd] = t1[rg] + o1[rg]; }
        if (h == 0) Lacc[rho] = lo + lsum;
    }
}
__device__ __forceinline__ void conv_rows(const bf16* UB, const float* cw, bf16* YA, int row0, int tid) {
    const int c8 = tid & 127, seg = tid >> 7, ch0 = 8 * c8, rbeg = row0 + 16 * seg, t0 = rbeg & (SEQ - 1);
    const f32x4 w0a = *(const f32x4*)(cw + ch0), w0b = *(const f32x4*)(cw + ch0 + 4), w1a = *(const f32x4*)(cw + 1024 + ch0), w1b = *(const f32x4*)(cw + 1024 + ch0 + 4), w2a = *(const f32x4*)(cw + 2048 + ch0), w2b = *(const f32x4*)(cw + 2048 + ch0 + 4);
    const bf16* ub = UB + (size_t)rbeg * 2048 + 16 * c8;
    f32x4 u1a = {}, u1b = {}, u2a = {}, u2b = {}, dmy;
    if (t0 >= 2) { pg8::unpack8(*(const GAS u32x4*)(ub - 4096), u2a, dmy); pg8::unpack8(*(const GAS u32x4*)(ub - 4096 + 8), u2b, dmy);
                   pg8::unpack8(*(const GAS u32x4*)(ub - 2048), u1a, dmy); pg8::unpack8(*(const GAS u32x4*)(ub - 2048 + 8), u1b, dmy); }
#pragma unroll
    for (int half = 0; half < 2; ++half) {
        u32x4 ra[8], rb[8];
#pragma unroll
        for (int i = 0; i < 8; ++i) { ra[i] = *(const GAS u32x4*)(ub + (size_t)(8 * half + i) * 2048); rb[i] = *(const GAS u32x4*)(ub + (size_t)(8 * half + i) * 2048 + 8); }
#pragma unroll
        for (int i = 0; i < 8; ++i) { f32x4 u0a, bza, u0b, bzb; pg8::unpack8(ra[i], u0a, bza); pg8::unpack8(rb[i], u0b, bzb);
            const f32x4 ya = bza * (w0a * u2a + w1a * u1a + w2a * u0a), yb = bzb * (w0b * u2b + w1b * u1b + w2b * u0b);
            *(GAS u32x4*)(YA + (size_t)(rbeg + 8 * half + i) * DM + ch0) = pg8::pack8(ya, yb);
            u2a = u1a; u2b = u1b; u1a = u0a; u1b = u0b; }
    }
}
__device__ __forceinline__ void attn_phase(Frame& F, const Args& a) {
    const bf16* Qn = (const bf16*)(a.ws + WS_Q); const bf16* Kn = (const bf16*)(a.ws + WS_K); const bf16* VT = (const bf16*)(a.ws + WS_VT); bf16* SZ = (bf16*)(a.ws + WS_SZ);
    const bf16* UB = (const bf16*)a.out; const float* cw = a.in[6]; const float* wq = a.in[7]; const float* wk = a.in[8];
    LAS float* Oacc = (LAS float*)F.lds; LAS float* Lacc = Oacc + 512 * 65;
    for (int blk = F.vcu; blk < M / 64; blk += F.G) conv_rows(UB, cw, (bf16*)(a.ws + WS_YA), blk * 64, F.tid);
    float mw = 0.f;
    for (int d = 0; d < 64; ++d) mw = fmaxf(mw, fabsf(wq[d] * wk[d]));
    const float shift = 64.f * mw * QSCALE * 1.02f + 0.5f;
    for (int unit = F.vcu; unit < 256; unit += F.G) {
        const int b = unit >> 7, j = (unit >> 4) & 7, tb = unit & 15, T0 = tb * 512;
#pragma unroll 1
        for (int gg = 0; gg < 3; ++gg) {
            attn_tile(Oacc, Lacc, Qn, Kn, VT, b, j, T0, 16 * gg + F.wave, F.lane, shift);
            attn_tile(Oacc, Lacc, Qn, Kn, VT, b, j, T0, 16 * gg + 8 + F.wave, F.lane, shift);
            __syncthreads();
        }
        { const int c = F.tid & 7; u32x4 zz[8];
#pragma unroll
          for (int ps = 0; ps < 8; ++ps) zz[ps] = *(const GAS u32x4*)(SZ + (size_t)(b * SEQ + T0 + (F.tid >> 3) + 64 * ps) * 512 + j * 64 + 8 * c);
#pragma unroll
          for (int ps = 0; ps < 8; ++ps) { const int tok = (F.tid >> 3) + 64 * ps, rho = rho512(tok); const size_t row = (size_t)(b * SEQ + T0 + tok);
              const float il = __builtin_amdgcn_rcpf(Lacc[rho]); const LAS float* op = Oacc + rho * 65 + 8 * c;
              f32x4 z0, z1; pg8::unpack8(zz[ps], z0, z1);
              f32x4 y0, y1;
#pragma unroll
              for (int i = 0; i < 4; ++i) { y0[i] = op[i] * il * z0[i]; y1[i] = op[4 + i] * il * z1[i]; }
              if (!a.pad) *(GAS u32x4*)(SZ + row * 512 + j * 64 + 8 * c) = pg8::pack8(y0, y1); } }
        __syncthreads();
    }
}

enum { PH_P0A = 0, PH_P0B, PH_G1, PH_ATT, PH_G2, PH_G3, PH_N };
__global__ void __launch_bounds__(NWAVES * 64, 2) mk_fwd(Args args) {
    extern __shared__ __attribute__((aligned(16))) unsigned char lds_raw[];
    Frame F;
    F.lds = (LAS unsigned char*)lds_raw; F.MISC = (volatile LAS unsigned*)(F.lds + MISC_OFF);
    F.tid = threadIdx.x; F.lane = F.tid & 63; F.wave = __builtin_amdgcn_readfirstlane(F.tid >> 6);
    F.G = gridDim.x; { const int bx = blockIdx.x; F.vcu = (F.G % 8 == 0) ? (bx % 8) * (F.G / 8) + bx / 8 : bx; }
    F.ctl = (gu32*)(args.ws + WS_CTL);
    for (int u = F.tid; u < (LDS_BYTES - LDSCTL_OFF) / 4; u += NWAVES * 64) ((LAS unsigned*)(F.lds + LDSCTL_OFF))[u] = 0u;
    __syncthreads();
    const int lo = args.ph_lo, hi = args.ph_hi;
    XcdBarrier bar; bar.bar = (unsigned*)(F.ctl + CW_BAR) + args.li * XCD_BAR_WORDS; bar.x = 0; bar.st = nullptr;
    if (hi - lo > 1) bar = xcd_barrier_post((unsigned*)(F.ctl + CW_BAR) + args.li * XCD_BAR_WORDS, F.MISC + 8);
#define IN(k) (lo <= (k) && (k) < hi)
#define SEAM(k) do { if (IN(k) && IN((k) + 1)) xcd_barrier(bar); } while (0)
    unsigned char* ws = args.ws;
#ifndef NO_P0
    if (IN(PH_P0A)) { p0a(F, args); SEAM(PH_P0A); }
    if (IN(PH_P0B)) { p0b(F, args); SEAM(PH_P0B); }
#endif
#ifndef NO_G1
    if (IN(PH_G1)) {
        pg8::SchedG1 S{(const char*)(ws + WS_XN), (const char*)(ws + WS_WALL), F.G, (int)blockIdx.x};
        pg8::EpiG1 E{(bf16*)args.out, (bf16*)(ws + WS_Q), (bf16*)(ws + WS_K), (bf16*)(ws + WS_VT), (bf16*)(ws + WS_SZ), args.in[7], args.in[8]};
        pg8::gemm_phase(F.lds, S, E); SEAM(PH_G1);
    }
#endif
#ifndef NO_ATT
    if (IN(PH_ATT)) { attn_phase(F, args); SEAM(PH_ATT); }
#endif
#ifndef NO_G2
    if (IN(PH_G2)) {
        pg8::SchedG2 S{(const char*)(ws + WS_XN), (const char*)(ws + WS_WALL), (const char*)(ws + WS_SZ), (const char*)(ws + WS_YA), (const char*)(ws + WS_PT), F.G, (int)blockIdx.x};
        pg8::EpiG2 E{(bf16*)(ws + WS_SA), (bf16*)(ws + WS_SB), (bf16*)(ws + WS_MG), args.out};
        pg8::gemm_phase(F.lds, S, E); SEAM(PH_G2);
    }
#endif
#ifndef NO_G3
    if (IN(PH_G3)) {
        pg8::SchedG3 S{(const char*)(ws + WS_MG), (const char*)(ws + WS_WOUT), F.G, (int)blockIdx.x};
        pg8::EpiG3 E{args.in[0], args.out, (const float*)(ws + WS_MODG)};
        pg8::gemm_phase(F.lds, S, E);
    }
#endif
#undef IN
#undef SEAM
}
static int g_grid = 0;
extern "C" void kernel_launch(void* const* d_in, const int* in_sizes, int n_in, void* d_out, int out_size, void* d_ws, size_t ws_size, hipStream_t stream) {
    if (g_grid == 0) {
        int dev = 0, cus = 0;
        (void)hipGetDevice(&dev); (void)hipDeviceGetAttribute(&cus, hipDeviceAttributeMultiprocessorCount, dev);
        (void)hipFuncSetAttribute((const void*)mk_fwd, hipFuncAttributeMaxDynamicSharedMemorySize, LDS_BYTES);
        (void)hipGetLastError();
        g_grid = cus > 0 ? cus : 256;
    }
    unsigned char* ws = (unsigned char*)d_ws;
    (void)hipMemsetAsync(ws + WS_CTL, 0, 64 * 1024, stream);
    Args a{}; for (int i = 0; i < 12; ++i) a.in[i] = (const float*)d_in[i]; a.out = (float*)d_out; a.ws = ws; a.ph_lo = 0; a.ph_hi = PH_N; a.li = 0; a.pad = 0;
#ifdef PHASE_LIST
    { const int pl[] = PHASE_LIST; for (int ph : pl) { a.pad = ph / 100; a.ph_lo = ph % 100; a.ph_hi = ph % 100 + 1; hipLaunchKernelGGL(mk_fwd, dim3(g_grid), dim3(NWAVES * 64), LDS_BYTES, stream, a); } }
#else
    hipLaunchKernelGGL(mk_fwd, dim3(g_grid), dim3(NWAVES * 64), LDS_BYTES, stream, a);
#endif
}
```

```cpp
#include <hip/hip_runtime.h>
#include <cstdint>
#include <cstdio>

typedef unsigned short bf16;
constexpr int BATCH = 2, SEQ = 8192, DM = 1024, M = BATCH * SEQ, NIN = 11264;
constexpr int OFF_B = 0, OFF_C = 1024, OFF_X = 2048, OFF_Z = 3072, OFF_Q = 4096, OFF_K = 5632, OFF_V = 7168, OFF_ZB = 8704, OFF_GA = 9216, OFF_GB = 10240;
constexpr int QKV = 1536;
constexpr float QSCALE = 0.125f * 1.4426950408889634f;
constexpr float EPS = 1e-6f;
constexpr size_t MiB = 1u << 20;
constexpr size_t WS_CTL = 0, WS_MOD = 512 * 1024;
constexpr size_t WS_XN = 28 * MiB, WS_Q = 60 * MiB, WS_K = 108 * MiB, WS_VT = 156 * MiB, WS_SZ = 204 * MiB, WS_S1 = 220 * MiB, WS_S2 = 236 * MiB;
constexpr size_t WS_SA = 108 * MiB, WS_SB = 140 * MiB, WS_MG = 172 * MiB;

__host__ __device__ __forceinline__ unsigned f2bf(float f) { unsigned u = __builtin_bit_cast(unsigned, f); return (u + 0x7fffu + ((u >> 16) & 1u)) >> 16; }
__host__ __device__ __forceinline__ float bf2f(unsigned h) { return __builtin_bit_cast(float, (h & 0xffffu) << 16); }
__host__ __device__ __forceinline__ float bfr(float f) { return bf2f(f2bf(f)); }
__host__ __device__ __forceinline__ int sigma16(int x) { return (x & 3) | ((x & 4) << 1) | ((x & 8) >> 1); }
__host__ __device__ __forceinline__ int vt_pos(int g, int t) { const int sh = 2 * g, r = t & ((1 << sh) - 1), l = t >> sh, L = SEQ >> sh; return r * L + (l & ~15) + sigma16(l & 15); }
__device__ __forceinline__ float silu_f(float v) { return v / (1.f + __expf(-v)); }
__device__ __forceinline__ float sigm_f(float v) { return 1.f / (1.f + __expf(-v)); }


#define LAS __attribute__((address_space(3)))
#define GAS __attribute__((address_space(1)))
typedef short bf16x8 __attribute__((ext_vector_type(8)));
typedef float f32x4 __attribute__((ext_vector_type(4)));
typedef float f32x16 __attribute__((ext_vector_type(16)));
typedef unsigned u32x4 __attribute__((ext_vector_type(4)));
typedef unsigned u32x2 __attribute__((ext_vector_type(2)));
typedef GAS unsigned gu32;
__device__ __forceinline__ __amdgpu_buffer_rsrc_t mk_rsrc(void* p, unsigned bytes) { return __builtin_amdgcn_make_buffer_rsrc(p, (short)0, (int)bytes, 0x00020000); }
#define RLX_AGENT __ATOMIC_RELAXED, __HIP_MEMORY_SCOPE_AGENT
#define LDS_WAIT() asm volatile("s_waitcnt lgkmcnt(0)" ::: "memory")
#define VM_WAIT() asm volatile("s_waitcnt vmcnt(0)" ::: "memory")

#ifndef MIDFLAG
#define MIDFLAG true
#endif
#ifndef CHAINFLAG
#define CHAINFLAG true
#endif
constexpr int NWAVES = 8;
constexpr size_t WS_MODP = 256 * 1024;
constexpr size_t WS_MODG = 768 * 1024;
constexpr size_t WS_WALL = 1 * MiB;
constexpr size_t WS_PT = 23 * MiB;
constexpr size_t WS_WOUT = 26 * MiB;
constexpr size_t WS_YA = 28 * MiB;
constexpr size_t WS_G8 = 220 * MiB;
constexpr size_t WS_T = 60 * MiB, WS_MG2 = 92 * MiB;
constexpr int ROW_WV = 7680, ROW_WG = 9216;
constexpr int CW_BAR = 4096;
constexpr int RING_BYTES = 131072, ATT_OACC_BYTES = 512 * 65 * 4, ATT_BYTES = ATT_OACC_BYTES + 2048;
constexpr int LDSCTL_OFF = 136192, MISC_OFF = LDSCTL_OFF + 320, LDS_BYTES = 147456;
static_assert(ATT_BYTES <= LDSCTL_OFF && MISC_OFF + 128 <= LDS_BYTES, "LDS map");

__device__ __forceinline__ unsigned cvt_pk_bf16(float lo, float hi) { unsigned r; asm volatile("v_cvt_pk_bf16_f32 %0, %1, %2" : "=v"(r) : "v"(lo), "v"(hi)); return r; }
__device__ __forceinline__ float fast_sigmoid(float v) { return __builtin_amdgcn_rcpf(1.f + __builtin_amdgcn_exp2f(-1.4426950408889634f * v)); }
__device__ __forceinline__ int tau256(int c) { return (c & ~15) + sigma16(c & 15); }
__device__ __forceinline__ int dst_win(int n) {
    if (n < 4096) { const int q = n >> 10, ch = n & 1023, tile = ch >> 6, cl = ch & 63, wc = cl >> 4, fq = (cl >> 2) & 3, i3 = cl & 3, bj = q >> 1, nn = q & 1; return 256 * tile + tau256(128 * bj + 32 * wc + 8 * fq + 4 * nn + i3); }
    if (n < 5632) { const int e = n - 4096, h = e >> 6, dd = e & 63; return 256 * (16 + (h >> 2)) + tau256(128 * (dd >> 5) + 32 * (h & 3) + (dd & 31)); }
    if (n < 7168) { const int e = n - 5632, h = e >> 6, dd = e & 63; return 256 * (22 + (h >> 2)) + tau256(128 * (dd >> 5) + 32 * (h & 3) + (dd & 31)); }
    if (n < 8704) return ROW_WV + (n - 7168);
    if (n < 9216) { const int e = n - 8704; return 256 * (28 + (e >> 8)) + tau256(e & 255); }
    const int e = n - 9216; return ROW_WG + (e & ~255) + tau256(e & 255);
}

#define XB_TMO      128
#define XB_XCNT(j)  (256  + 64 * (j))
#define XB_XSUB(j)  (1280 + 64 * (j))
#define XB_XGEN(j)  (2304 + 64 * (j))
#define XB_TOP      3328
#define XB_TOPGEN   3392
#define XCD_BAR_WORDS 3456
#define XB_SPIN_CAP (1u << 18)
__device__ __forceinline__ unsigned xb_ld(unsigned* p)              { return __hip_atomic_load(p, __ATOMIC_RELAXED, __HIP_MEMORY_SCOPE_AGENT); }
__device__ __forceinline__ unsigned xb_add(unsigned* p, unsigned v) { return __hip_atomic_fetch_add(p, v, __ATOMIC_RELAXED, __HIP_MEMORY_SCOPE_AGENT); }
__device__ __forceinline__ unsigned xb_xcc_id() { return (unsigned)__builtin_amdgcn_s_getreg((3 << 11) | 20) & 0xFu; }
#define XB_SPIN(cond, bar) do { unsigned _sp = 0; while (cond) { __builtin_amdgcn_s_sleep(1); \
    if ((++_sp & 255u) == 0u) { if (xb_ld(&(bar)[XB_TMO])) break; if (_sp > XB_SPIN_CAP) { atomicAdd(&(bar)[XB_TMO], 1u); break; } } } } while (0)
struct XcdBarrier { unsigned* bar; unsigned x; volatile LAS unsigned* st; };
__device__ __forceinline__ XcdBarrier xcd_barrier_post(unsigned* bar, volatile LAS unsigned* st) {
    XcdBarrier b; b.bar = bar; b.x = xb_xcc_id(); b.st = st;
    if (threadIdx.x == 0) (void)xb_add(&bar[XB_XCNT(b.x)], 1u);
    return b;
}
__device__ __forceinline__ void xcd_barrier_complete(unsigned* bar, unsigned x, unsigned& nloc, unsigned& nx) {
    const unsigned G = gridDim.x * gridDim.y * gridDim.z;
    unsigned sum, cnt, mine, sp = 0u;
    for (;;) {
        sum = 0u; cnt = 0u; mine = 0u;
#pragma unroll
        for (unsigned j = 0; j < 16; ++j) { const unsigned c = xb_ld(&bar[XB_XCNT(j)]); sum += c; cnt += (c > 0u) ? 1u : 0u; mine = (j == x) ? c : mine; }
        if (sum == G) break;
        __builtin_amdgcn_s_sleep(1);
        if ((++sp & 255u) == 0u) { if (xb_ld(&bar[XB_TMO])) break; if (sp > XB_SPIN_CAP) { atomicAdd(&bar[XB_TMO], 1u); break; } }
    }
    nloc = mine > 0u ? mine : 1u; nx = cnt > 0u ? cnt : 1u;
}
__device__ __forceinline__ void xcd_barrier(const XcdBarrier& b) {
    asm volatile("s_waitcnt vmcnt(0)" ::: "memory");
    __syncthreads();
    if (threadIdx.x == 0) {
        unsigned* bar = b.bar;
        __builtin_amdgcn_s_waitcnt(0);
        unsigned nloc = b.st[0], nx = b.st[1];
        if (nloc == 0u) { xcd_barrier_complete(bar, b.x, nloc, nx); b.st[0] = nloc; b.st[1] = nx; }
        const unsigned old = xb_add(&bar[XB_XSUB(b.x)], 1u);
        const unsigned gen = old / nloc;
        if (old + 1u == (gen + 1u) * nloc) {
            __builtin_amdgcn_fence(__ATOMIC_RELEASE, "agent");
            asm volatile("s_waitcnt vmcnt(0)" ::: "memory");
            const unsigned og = xb_add(&bar[XB_TOP], 1u);
            const unsigned tg = og / nx;
            if (og + 1u == (tg + 1u) * nx) xb_add(&bar[XB_TOPGEN], 1u);
            else XB_SPIN(xb_ld(&bar[XB_TOPGEN]) == tg, bar);
            __builtin_amdgcn_fence(__ATOMIC_ACQUIRE, "agent");
            xb_add(&bar[XB_XGEN(b.x)], 1u);
            asm volatile("s_waitcnt vmcnt(0)" ::: "memory");
        } else {
            XB_SPIN(xb_ld(&bar[XB_XGEN(b.x)]) == gen, bar);
            __builtin_amdgcn_fence(__ATOMIC_ACQUIRE, "agent");
            asm volatile("s_waitcnt vmcnt(0)" ::: "memory");
        }
    }
    __syncthreads();
}

namespace pg8 {
constexpr int BM = 256, BK = 64, HALF = 128, HTB = HALF * BK * 2, NXCD = 8, WGM = 8;
__host__ __device__ __forceinline__ int lds_byte(int r, int c) { const int st = (r >> 4) * 2 + (c >> 5), rr = r & 15, cc = c & 31, ob = rr * 64 + cc * 2; return st * 1024 + (ob ^ (((ob >> 9) & 1) << 5)); }
__host__ __device__ __forceinline__ void stage_rc(int b, int& R, int& C) { const int st = b / 1024, sb = b % 1024, swz = sb ^ (((sb >> 9) & 1) << 5); R = (st >> 1) * 16 + swz / 64; C = (st & 1) * 32 + (swz % 64) / 2; }
__host__ __device__ __forceinline__ int perm32(int rho) { const int n = rho >> 4, i = rho & 15; return 8 * (i >> 2) + 4 * n + (i & 3); }
__device__ __forceinline__ void tile_of(int L, int nM, int nN, int& pm, int& pn) {
    const int nwg = nM * nN; int wgid = L; { const int q = nwg / NXCD, r = nwg % NXCD, xcd = wgid % NXCD, off = wgid / NXCD; wgid = (xcd < r ? xcd * (q + 1) : r * (q + 1) + (xcd - r) * q) + off; }
    const int nig = WGM * nN, gid = wgid / nig, fm = gid * WGM, gsz = (nM - fm) < WGM ? (nM - fm) : WGM;
    pm = fm + ((wgid % nig) % gsz); pn = (wgid % nig) / gsz;
}
enum { K_CONV = 0, K_Q, K_K, K_ZB, K_V, K_GA, K_GB, K_MB, K_MERGE, K_OUT };
struct UnitD { const char* A; const char* B; unsigned pA, pB; int nt, kind, pm, pn; };

template <class Epi, class Sched>
__device__ __forceinline__ void gemm_phase(LAS unsigned char* lds, const Sched& S, const Epi& E, const int dry = 0) {
    const int tid = threadIdx.x, wid = __builtin_amdgcn_readfirstlane(tid >> 6), lane = tid & 63, wr = wid >> 2, wc = wid & 3, fr = lane & 15, fq = lane >> 4;
    unsigned rowA[2], rowB[2], col2[2];
#pragma unroll
    for (int i = 0; i < 2; ++i) { int R, C; stage_rc(tid * 16 + i * 8192, R, C); const int Rb = (R & ~31) + perm32(R & 31);
        rowA[i] = (unsigned)R; rowB[i] = (unsigned)tau256(Rb); col2[i] = (unsigned)C * 2u; }
    const size_t kstep = (size_t)(BK * 2);
    const unsigned ldsw = (unsigned)wid * 1024u;
    const int aoff = lds_byte(wr * 64 + fr, fq * 8), boff = lds_byte(wc * 32 + fr, fq * 8);
#define PG8_SA(b, h) (((b) * 2 + (h)) * HTB)
#define PG8_SB(b, h) ((4 + (b) * 2 + (h)) * HTB)
#define PG8_STAGE(bufoff, gbase, rowv, pitch) do { _Pragma("unroll") for (int _i = 0; _i < 2; ++_i) \
        __builtin_amdgcn_global_load_lds((const unsigned*)((const char*)(gbase) + (rowv[_i] * (pitch) + col2[_i])), (LAS unsigned*)(lds + (bufoff) + ldsw + _i * 8192), 16, 0, 0); } while (0)
#define PG8_LDA(dst, b, h) do { _Pragma("unroll") for (int m = 0; m < 4; ++m) _Pragma("unroll") for (int k = 0; k < 2; ++k) dst[m][k] = *(const LAS bf16x8*)(lds + PG8_SA(b, h) + aoff + m * 2048 + k * 1024); } while (0)
#define PG8_LDB(dst, b, h) do { _Pragma("unroll") for (int n = 0; n < 2; ++n) _Pragma("unroll") for (int k = 0; k < 2; ++k) dst[n][k] = *(const LAS bf16x8*)(lds + PG8_SB(b, h) + boff + n * 2048 + k * 1024); } while (0)
#define PG8_MMA(ai, bj, At, Bt) do { __builtin_amdgcn_s_setprio(1); _Pragma("unroll") for (int m = 0; m < 4; ++m) _Pragma("unroll") for (int n = 0; n < 2; ++n) _Pragma("unroll") for (int k = 0; k < 2; ++k) \
        acc[ai][bj][m][n] = __builtin_amdgcn_mfma_f32_16x16x32_bf16(Bt[n][k], At[m][k], acc[ai][bj][m][n], 0, 0, 0); __builtin_amdgcn_s_setprio(0); } while (0)
#define PG8_WAIT_V(n) asm volatile("s_waitcnt vmcnt(" #n ")" ::: "memory")
#define PG8_WAIT_L(n) asm volatile("s_waitcnt lgkmcnt(" #n ")" ::: "memory")
#define PG8_BAR __builtin_amdgcn_s_barrier()
#define PG8_SCHED __builtin_amdgcn_sched_barrier(0)
    UnitD cur, nxt; int ui = 0;
    if (!S.next(0, cur)) return;
    f32x4 acc[2][2][4][2];
#pragma unroll
    for (int a = 0; a < 2; ++a)
#pragma unroll
        for (int b = 0; b < 2; ++b)
#pragma unroll
            for (int m = 0; m < 4; ++m)
#pragma unroll
                for (int n = 0; n < 2; ++n) acc[a][b][m][n] = (f32x4){0.f, 0.f, 0.f, 0.f};
    bf16x8 At[4][2], B0[2][2], B1[2][2];
    const char* cA = cur.A; const char* cB = cur.B;
    {   const unsigned pA = cur.pA, pB = cur.pB; const size_t hA = (size_t)HALF * pA, hB = (size_t)HALF * pB;
        PG8_STAGE(PG8_SB(0, 0), cB, rowB, pB); PG8_STAGE(PG8_SB(0, 1), cB + hB, rowB, pB); PG8_STAGE(PG8_SA(0, 0), cA, rowA, pA); PG8_STAGE(PG8_SA(0, 1), cA + hA, rowA, pA);
        if (wr == 1) PG8_BAR;
        PG8_WAIT_V(2); PG8_BAR;
        PG8_STAGE(PG8_SB(1, 0), cB + kstep, rowB, pB); PG8_STAGE(PG8_SA(1, 0), cA + kstep, rowA, pA); PG8_STAGE(PG8_SB(1, 1), cB + hB + kstep, rowB, pB);
        PG8_WAIT_V(6); PG8_BAR;
    }
    for (;;) {
        const bool has_next = S.next(ui + 1, nxt);
        const char* nA = has_next ? nxt.A : cA; const char* nB = has_next ? nxt.B : cB;
        const unsigned npA = has_next ? nxt.pA : cur.pA, npB = has_next ? nxt.pB : cur.pB;
        const unsigned pA = cur.pA; const size_t hA = (size_t)HALF * pA;
        const int nt = cur.nt;
        for (int t = 0; t < nt; t += 2) {
            const bool last = (t == nt - 2);
            const char* a1 = cA + (size_t)(t + 1) * kstep;
            const char* a2 = last ? nA : cA + (size_t)(t + 2) * kstep; const char* b2 = last ? nB : cB + (size_t)(t + 2) * kstep;
            const unsigned p2A = last ? npA : pA, p2B = last ? npB : cur.pB; const size_t h2A = (size_t)HALF * p2A, h2B = (size_t)HALF * p2B;
            const char* a3 = a2 + kstep; const char* b3 = b2 + kstep;
            PG8_LDB(B0, 0, 0); PG8_LDB(B1, 0, 1); PG8_SCHED; PG8_LDA(At, 0, 0); PG8_STAGE(PG8_SA(1, 1), a1 + hA, rowA, pA);
            PG8_WAIT_V(8); PG8_WAIT_L(0); PG8_BAR; PG8_MMA(0, 0, At, B0); PG8_MMA(0, 1, At, B1); PG8_BAR; PG8_SCHED;
            PG8_LDA(At, 0, 1); PG8_STAGE(PG8_SB(0, 0), b2, rowB, p2B); PG8_STAGE(PG8_SB(0, 1), b2 + h2B, rowB, p2B); PG8_STAGE(PG8_SA(0, 0), a2, rowA, p2A);
            PG8_WAIT_V(8); PG8_WAIT_L(0); PG8_BAR; PG8_MMA(1, 0, At, B0); PG8_MMA(1, 1, At, B1); PG8_BAR; PG8_SCHED;
            PG8_LDB(B0, 1, 0); PG8_LDB(B1, 1, 1); PG8_SCHED; PG8_LDA(At, 1, 0); PG8_STAGE(PG8_SA(0, 1), a2 + h2A, rowA, p2A);
            PG8_WAIT_V(8); PG8_WAIT_L(0); PG8_BAR; PG8_MMA(0, 0, At, B0); PG8_MMA(0, 1, At, B1); PG8_BAR; PG8_SCHED;
            PG8_LDA(At, 1, 1); PG8_STAGE(PG8_SB(1, 0), b3, rowB, p2B); PG8_STAGE(PG8_SB(1, 1), b3 + h2B, rowB, p2B); PG8_STAGE(PG8_SA(1, 0), a3, rowA, p2A);
            PG8_WAIT_V(8); PG8_WAIT_L(0); PG8_BAR; PG8_MMA(1, 0, At, B0); PG8_MMA(1, 1, At, B1); PG8_BAR; PG8_SCHED;
        }
        if (wr == 0) PG8_BAR;
        if (Epi::HAS_CHAIN && cur.kind == K_MB) { E.rescale(acc, cur, wr, wc, fr, fq); }
        else {
        if (!dry) E(acc, cur, wr, wc, fr, fq); else { if (acc[0][0][0][0][0] == 123.456f) E(acc, cur, wr, wc, fr, fq); }
        if (!has_next) break;
#pragma unroll
        for (int a = 0; a < 2; ++a)
#pragma unroll
            for (int b = 0; b < 2; ++b)
#pragma unroll
                for (int m = 0; m < 4; ++m)
#pragma unroll
                    for (int n = 0; n < 2; ++n) acc[a][b][m][n] = (f32x4){0.f, 0.f, 0.f, 0.f};
        }
        cur = nxt; cA = nA; cB = nB; ++ui;
        if (wr == 1) PG8_BAR;
    }
    PG8_WAIT_V(0);
    PG8_BAR;
#undef PG8_SA
#undef PG8_SB
#undef PG8_STAGE
#undef PG8_LDA
#undef PG8_LDB
#undef PG8_MMA
#undef PG8_WAIT_V
#undef PG8_WAIT_L
#undef PG8_BAR
#undef PG8_SCHED
}

__device__ __forceinline__ u32x4 pack8(const f32x4 a, const f32x4 b) { u32x4 w; w.x = cvt_pk_bf16(a[0], a[1]); w.y = cvt_pk_bf16(a[2], a[3]); w.z = cvt_pk_bf16(b[0], b[1]); w.w = cvt_pk_bf16(b[2], b[3]); return w; }
__device__ __forceinline__ void unpack8(const u32x4 w, f32x4& a, f32x4& b) {
    a[0] = __uint_as_float(w.x << 16); a[1] = __uint_as_float(w.x & 0xffff0000u); a[2] = __uint_as_float(w.y << 16); a[3] = __uint_as_float(w.y & 0xffff0000u);
    b[0] = __uint_as_float(w.z << 16); b[1] = __uint_as_float(w.z & 0xffff0000u); b[2] = __uint_as_float(w.w << 16); b[3] = __uint_as_float(w.w & 0xffff0000u); }

#define LD16(base, off) (*(const u32x4*)((const char*)(base) + (unsigned)(off)))
#define ST16(base, off, v) (*(u32x4*)((char*)(base) + (unsigned)(off)) = (v))
#ifndef WT_AUX
#define WT_AUX 0
#endif
typedef __amdgpu_buffer_rsrc_t rsrc_t;
#define WT16(rs, off, v) __builtin_amdgcn_raw_buffer_store_b128((v), (rs), (unsigned)(off), 0, WT_AUX)
#define WT8(rs, off, v) __builtin_amdgcn_raw_buffer_store_b64((v), (rs), (unsigned)(off), 0, WT_AUX)
struct EpiG1 {
    static constexpr bool HAS_CHAIN = false;
    __device__ __forceinline__ void rescale(f32x4 (&)[2][2][4][2], const UnitD&, int, int, int, int) const {}
    rsrc_t UB, Qn, Kn, VT, SZ, G8; const float* wq; const float* wk;
    __device__ __forceinline__ void operator()(f32x4 (&acc)[2][2][4][2], const UnitD& u, int wr, int wc, int fr, int fq) const {
        const unsigned row0 = (unsigned)(u.pm * BM + wr * 64 + fr);
        if (u.kind == K_CONV) {
            const unsigned o0 = row0 * 4096u + (unsigned)(16 * u.pn + 4 * wc + fq) * 16u;
#pragma unroll
            for (int ai = 0; ai < 2; ++ai)
#pragma unroll
                for (int m = 0; m < 4; ++m) { const f32x4 b = acc[ai][0][m][0], c = acc[ai][0][m][1], x = acc[ai][1][m][0], z = acc[ai][1][m][1]; f32x4 uu = c * x, bz;
#pragma unroll
                    for (int i = 0; i < 4; ++i) bz[i] = b[i] * z[i] * fast_sigmoid(z[i]);
                    WT16(UB, o0 + (unsigned)(ai * HALF + m * 16) * 4096u, pack8(uu, bz)); }
        } else if (u.kind == K_Q || u.kind == K_K) {
            const bool isq = (u.kind == K_Q); const float* w = isq ? wq : wk; const float sc = isq ? QSCALE : 1.0f;
            const int head = 4 * u.pn + wc, sh = 2 * (u.pn >> 1), bb = u.pm >> 5, tbase = (u.pm & 31) * 256 + wr * 64 + fr;
            const unsigned o0 = ((unsigned)(bb * 24 + head) << 20) + ((unsigned)fq << 9);
            f32x4 wv[2][2];
#pragma unroll
            for (int bj = 0; bj < 2; ++bj)
#pragma unroll
                for (int n = 0; n < 2; ++n) wv[bj][n] = *(const f32x4*)(w + 32 * bj + 8 * fq + 4 * n);
#pragma unroll
            for (int ai = 0; ai < 2; ++ai)
#pragma unroll
                for (int m = 0; m < 4; ++m) { float ss = 0.f;
#pragma unroll
                    for (int bj = 0; bj < 2; ++bj)
#pragma unroll
                        for (int n = 0; n < 2; ++n) { const f32x4 v = acc[ai][bj][m][n]; ss += (v[0] * v[0] + v[1] * v[1]) + (v[2] * v[2] + v[3] * v[3]); }
                    ss += __shfl_xor(ss, 16); ss += __shfl_xor(ss, 32);
                    const float r = __builtin_amdgcn_rsqf(ss * (1.f / 64.f) + EPS) * sc;
                    const int t = tbase + ai * HALF + m * 16, pos = (t & ((1 << sh) - 1)) * (SEQ >> sh) + (t >> sh); const unsigned o = o0 + ((unsigned)pos << 7 & ~4095u) + ((unsigned)(pos & 31) << 4);
#pragma unroll
                    for (int bj = 0; bj < 2; ++bj) { const u32x4 pk = pack8(acc[ai][bj][m][0] * r * wv[bj][0], acc[ai][bj][m][1] * r * wv[bj][1]); if (isq) WT16(Qn, o + 2048u * bj, pk); else WT16(Kn, o + 2048u * bj, pk); } }
        } else if (u.kind == K_ZB) {
            const unsigned o0 = row0 * 1024u + (unsigned)(256 * u.pn + 32 * wc + 8 * fq) * 2u;
#pragma unroll
            for (int ai = 0; ai < 2; ++ai)
#pragma unroll
                for (int m = 0; m < 4; ++m)
#pragma unroll
                    for (int bj = 0; bj < 2; ++bj) { f32x4 v0 = acc[ai][bj][m][0], v1 = acc[ai][bj][m][1];
#pragma unroll
                        for (int i = 0; i < 4; ++i) { v0[i] = v0[i] * fast_sigmoid(v0[i]); v1[i] = v1[i] * fast_sigmoid(v1[i]); }
                        WT16(SZ, o0 + (unsigned)(ai * HALF + m * 16) * 1024u + 256u * bj, pack8(v0, v1)); }
        } else if (u.kind == K_GA || u.kind == K_GB) {
            const unsigned o0 = row0 * 2048u + (unsigned)((256 * u.pn + 32 * wc + 8 * fq) >> 3) * 16u + (u.kind == K_GB ? 8u : 0u);
#pragma unroll
            for (int ai = 0; ai < 2; ++ai)
#pragma unroll
                for (int m = 0; m < 4; ++m)
#pragma unroll
                    for (int bj = 0; bj < 2; ++bj) { const f32x4 v0 = acc[ai][bj][m][0], v1 = acc[ai][bj][m][1]; unsigned lo = 0u, hi = 0u;
                        lo = __builtin_amdgcn_cvt_pk_u8_f32(__builtin_rintf(fast_sigmoid(v0[0]) * 255.f), 0, lo); lo = __builtin_amdgcn_cvt_pk_u8_f32(__builtin_rintf(fast_sigmoid(v0[1]) * 255.f), 1, lo);
                        lo = __builtin_amdgcn_cvt_pk_u8_f32(__builtin_rintf(fast_sigmoid(v0[2]) * 255.f), 2, lo); lo = __builtin_amdgcn_cvt_pk_u8_f32(__builtin_rintf(fast_sigmoid(v0[3]) * 255.f), 3, lo);
                        hi = __builtin_amdgcn_cvt_pk_u8_f32(__builtin_rintf(fast_sigmoid(v1[0]) * 255.f), 0, hi); hi = __builtin_amdgcn_cvt_pk_u8_f32(__builtin_rintf(fast_sigmoid(v1[1]) * 255.f), 1, hi);
                        hi = __builtin_amdgcn_cvt_pk_u8_f32(__builtin_rintf(fast_sigmoid(v1[2]) * 255.f), 2, hi); hi = __builtin_amdgcn_cvt_pk_u8_f32(__builtin_rintf(fast_sigmoid(v1[3]) * 255.f), 3, hi);
                        u32x2 w; w.x = lo; w.y = hi; WT8(G8, o0 + (unsigned)(ai * HALF + m * 16) * 2048u + 256u * bj, w); }
        } else {
            const int bb = u.pn >> 5, blk0 = 8 * (u.pn & 31) + wc;
#pragma unroll
            for (int ai = 0; ai < 2; ++ai) { const unsigned oh = ((unsigned)(bb * 24 + 4 * u.pm + 2 * ai + wr) << 20) + ((unsigned)blk0 << 12) + ((unsigned)fq << 9) + ((unsigned)fr << 4);
#pragma unroll
                for (int m = 0; m < 4; ++m)
#pragma unroll
                    for (int bj = 0; bj < 2; ++bj) WT16(VT, oh + (unsigned)(4 * bj << 12) + (unsigned)((4 * (m >> 1)) << 9) + (unsigned)((16 * (m & 1)) << 4), pack8(acc[ai][bj][m][0], acc[ai][bj][m][1])); }
        }
    }
};
__device__ __forceinline__ void unpack_u8x4(unsigned w, f32x4& v) { v[0] = (float)(w & 0xffu); v[1] = (float)((w >> 8) & 0xffu); v[2] = (float)((w >> 16) & 0xffu); v[3] = (float)(w >> 24); v = v * (1.f / 255.f); }
struct EpiG2 {
    static constexpr bool HAS_CHAIN = false;
    __device__ __forceinline__ void rescale(f32x4 (&)[2][2][4][2], const UnitD&, int, int, int, int) const {}
    const unsigned char* G8; bf16* T; rsrc_t MG;
    __device__ __forceinline__ void operator()(f32x4 (&acc)[2][2][4][2], const UnitD& u, int wr, int wc, int fr, int fq) const {
        const unsigned o0 = (unsigned)(u.pm * BM + wr * 64 + fr) * 2048u + (unsigned)(256 * u.pn + 32 * wc + 8 * fq) * 2u;
        if (u.kind == K_MB) {
#pragma unroll
            for (int ai = 0; ai < 2; ++ai)
#pragma unroll
                for (int m = 0; m < 4; ++m)
#pragma unroll
                    for (int bj = 0; bj < 2; ++bj) { const unsigned o = o0 + (unsigned)(ai * HALF + m * 16) * 2048u + 256u * bj; const u32x2 g = *(const u32x2*)((const char*)G8 + o + 8u);
                        f32x4 b0, b1; unpack_u8x4(g.x, b0); unpack_u8x4(g.y, b1);
                        ST16(T, o, pack8(acc[ai][bj][m][0] * b0, acc[ai][bj][m][1] * b1)); if (bj == 1) asm volatile("" ::: "memory"); }
        } else {
#pragma unroll
            for (int ai = 0; ai < 2; ++ai)
#pragma unroll
                for (int m = 0; m < 4; ++m)
#pragma unroll
                    for (int bj = 0; bj < 2; ++bj) { const unsigned o = o0 + (unsigned)(ai * HALF + m * 16) * 2048u + 256u * bj; const u32x2 g = *(const u32x2*)((const char*)G8 + o);
                        f32x4 a0, a1, t0, t1; unpack_u8x4(g.x, a0); unpack_u8x4(g.y, a1); unpack8(LD16(T, o), t0, t1);
                        WT16(MG, o, pack8(acc[ai][bj][m][0] * a0 + t0, acc[ai][bj][m][1] * a1 + t1)); if (bj == 1) asm volatile("" ::: "memory"); }
        }
    }
};
struct EpiG3 {
    static constexpr bool HAS_CHAIN = false;
    __device__ __forceinline__ void rescale(f32x4 (&)[2][2][4][2], const UnitD&, int, int, int, int) const {}
    const float* x; float* out; const float* gate;
    __device__ __forceinline__ void operator()(f32x4 (&acc)[2][2][4][2], const UnitD& u, int wr, int wc, int fr, int fq) const {
        const int col0 = 256 * u.pn + 32 * wc + 8 * fq; const float* gp = gate + (u.pm >> 5) * DM + col0;
        f32x4 gv[2][2];
#pragma unroll
        for (int bj = 0; bj < 2; ++bj)
#pragma unroll
            for (int n = 0; n < 2; ++n) gv[bj][n] = *(const f32x4*)(gp + bj * HALF + 4 * n);
        const unsigned o0 = (unsigned)(u.pm * BM + wr * 64 + fr) * 4096u + (unsigned)col0 * 4u;
#pragma unroll
        for (int ai = 0; ai < 2; ++ai)
#pragma unroll
            for (int m = 0; m < 4; ++m) {
#pragma unroll
                for (int bj = 0; bj < 2; ++bj)
#pragma unroll
                    for (int n = 0; n < 2; ++n) { const unsigned o = o0 + (unsigned)(ai * HALF + m * 16) * 4096u + 512u * bj + 16u * n;
                        *(f32x4*)((char*)out + o) = *(const f32x4*)((const char*)x + o) + gv[bj][n] * acc[ai][bj][m][n]; }
                if (m & 1) asm volatile("" ::: "memory"); }
    }
};
struct SchedG1 {
    const char* XN; const char* WALL; int G, c;
    __device__ __forceinline__ bool next(int i, UnitD& u) const {
        const int L = i * G + c; if (L >= 2816) return false;
        if (L < 2432) { int pm, pn; tile_of(L, 64, 38, pm, pn); u.A = XN + (size_t)pm * (256 * 2048); u.B = WALL + (size_t)(pn < 30 ? pn * 256 : ROW_WG + (pn - 30) * 256) * 2048; u.pA = 2048u; u.pB = 2048u; u.nt = 16; u.pm = pm;
            if (pn < 16) { u.kind = K_CONV; u.pn = pn; } else if (pn < 22) { u.kind = K_Q; u.pn = pn - 16; } else if (pn < 28) { u.kind = K_K; u.pn = pn - 22; } else if (pn < 30) { u.kind = K_ZB; u.pn = pn - 28; }
            else if (pn < 34) { u.kind = K_GA; u.pn = pn - 30; } else { u.kind = K_GB; u.pn = pn - 34; }
        } else { int pm, pn; tile_of(L - 2432, 6, 64, pm, pn); const int sh = 2 * (pm >> 1), b = pn >> 5, q = pn & 31, tpr = 32 >> sh, r = q / tpr, l0 = 256 * (q % tpr);
            u.A = WALL + (size_t)(ROW_WV + 256 * pm) * 2048; u.B = XN + (size_t)(b * SEQ + (l0 << sh) + r) * 2048; u.pA = 2048u; u.pB = 2048u << sh; u.nt = 16; u.kind = K_V; u.pm = pm; u.pn = pn; }
        return true;
    }
};
struct SchedG2 {
    const char* YB; const char* YA; const char* PT; int G, c;
    __device__ __forceinline__ bool next(int i, UnitD& u) const {
        const int j = i >> 1, sub = i & 1, L = j * G + c; if (L >= 256) return false;
        int pm, pn; tile_of(L, 64, 4, pm, pn); u.pm = pm; u.pn = pn;
        if (sub == 0) { u.A = YB + (size_t)pm * (256 * 1024); u.B = PT + (size_t)pn * (256 * 3072); u.pA = 1024u; u.pB = 3072u; u.nt = 8; u.kind = K_MB; }
        else { u.A = YA + (size_t)pm * (256 * 2048); u.B = PT + (size_t)pn * (256 * 3072) + 1024; u.pA = 2048u; u.pB = 3072u; u.nt = 16; u.kind = K_MERGE; }
        return true;
    }
};
struct SchedG3 {
    const char* MGp; const char* WOUT; int G, c;
    __device__ __forceinline__ bool next(int i, UnitD& u) const {
        const int L = i * G + c; if (L >= 256) return false;
        int pm, pn; tile_of(L, 64, 4, pm, pn); u.pm = pm; u.pn = pn; u.A = MGp + (size_t)pm * (256 * 2048); u.B = WOUT + (size_t)pn * (256 * 2048); u.pA = 2048u; u.pB = 2048u; u.nt = 16; u.kind = K_OUT; return true;
    }
};
}

struct Frame {
    LAS unsigned char* lds; volatile LAS unsigned* MISC; gu32* ctl;
    int tid, lane, wave, vcu, G;
};
struct Args { const float* in[12]; float* out; unsigned char* ws; int ph_lo, ph_hi, li, pad; };

__device__ __forceinline__ float wave_sum(float v) {
#pragma unroll
    for (int o = 1; o < 64; o <<= 1) v += __shfl_xor(v, o);
    return v;
}
template <class RowMap>
__device__ __forceinline__ void p0_transpose_item(const float* W, int N, bf16* WT, int pitch, int koff, LAS float* scr, int k0, int n0, int lane, const RowMap& rm) {
    f32x4 v[8]; const int kr = lane >> 3, c4 = (lane & 7) * 4;
#pragma unroll
    for (int i = 0; i < 8; ++i) v[i] = *(const GAS f32x4*)(W + (size_t)(k0 + 8 * i + kr) * N + n0 + c4);
#pragma unroll
    for (int i = 0; i < 8; ++i) { LAS float* d = scr + (8 * i + kr) * 33 + c4; d[0] = v[i][0]; d[1] = v[i][1]; d[2] = v[i][2]; d[3] = v[i][3]; }
    LDS_WAIT(); asm volatile("" ::: "memory");
    const int c = lane & 7;
#pragma unroll
    for (int j = 0; j < 4; ++j) { const int n = (lane >> 3) + 8 * j; const LAS float* s = scr + (8 * c) * 33 + n;
        u32x4 o; o.x = cvt_pk_bf16(s[0 * 33], s[1 * 33]); o.y = cvt_pk_bf16(s[2 * 33], s[3 * 33]); o.z = cvt_pk_bf16(s[4 * 33], s[5 * 33]); o.w = cvt_pk_bf16(s[6 * 33], s[7 * 33]);
        *(GAS u32x4*)(WT + (size_t)rm(n0 + n) * pitch + koff + k0 + 8 * c) = o; }
    LDS_WAIT(); asm volatile("" ::: "memory");
}
struct RmWin { __device__ __forceinline__ int operator()(int n) const { return dst_win(n); } };
struct RmTau { __device__ __forceinline__ int operator()(int n) const { return (n & ~255) + tau256(n & 255); } };

__device__ __forceinline__ void p0a(Frame& F, const Args& a) {
    LAS float* scr = (LAS float*)(F.lds + F.wave * 16384);
    const int gw = F.vcu * NWAVES + F.wave, NGW = F.G * NWAVES;
    const float* w_in = a.in[5]; const float* w_brc = a.in[9]; const float* w_bra = a.in[10]; const float* w_out = a.in[11];
    bf16* WALL = (bf16*)(a.ws + WS_WALL); bf16* PT = (bf16*)(a.ws + WS_PT); bf16* WOUT = (bf16*)(a.ws + WS_WOUT);
    constexpr int I_IN = 16 * 352, I_C = 16 * 32, I_A = 8 * 32, I_O = 16 * 32, NITEMS = I_IN + I_C + I_A + I_O;
    { const float* c = a.in[1]; const float* w_ada = a.in[2]; float* modp = (float*)(a.ws + WS_MODP);
      for (int it = gw; it < 768; it += NGW) { const int cch = it % 96, ks = it / 96, c4 = 32 * cch + (F.lane & 7) * 4, kr = ks * 128 + (F.lane >> 3);
          f32x4 w[16]; float s0[16], s1[16];
#pragma unroll
          for (int i = 0; i < 16; ++i) w[i] = *(const GAS f32x4*)(w_ada + (size_t)(kr + 8 * i) * 3072 + c4);
#pragma unroll
          for (int i = 0; i < 16; ++i) { const float c0 = c[kr + 8 * i], c1 = c[DM + kr + 8 * i]; s0[i] = c0 * fast_sigmoid(c0); s1[i] = c1 * fast_sigmoid(c1); }
          f32x4 a0 = {0.f, 0.f, 0.f, 0.f}, a1 = {0.f, 0.f, 0.f, 0.f};
#pragma unroll
          for (int i = 0; i < 16; ++i) { a0 += w[i] * s0[i]; a1 += w[i] * s1[i]; }
#pragma unroll
          for (int o = 8; o < 64; o <<= 1)
#pragma unroll
              for (int e = 0; e < 4; ++e) { a0[e] += __shfl_xor(a0[e], o); a1[e] += __shfl_xor(a1[e], o); }
          if (F.lane < 8) { *(GAS f32x4*)(modp + (size_t)(ks * 2 + 0) * 3072 + c4) = a0; *(GAS f32x4*)(modp + (size_t)(ks * 2 + 1) * 3072 + c4) = a1; } } }
    for (int it = gw; it < NITEMS; it += NGW) {
        int r = it;
        if (r < I_IN) { p0_transpose_item(w_in, NIN, WALL, 1024, 0, scr, 64 * (r / 352), 32 * (r % 352), F.lane, RmWin()); continue; } r -= I_IN;
        if (r < I_C) { p0_transpose_item(w_brc, DM, PT, 1536, 512, scr, 64 * (r / 32), 32 * (r % 32), F.lane, RmTau()); continue; } r -= I_C;
        if (r < I_A) { p0_transpose_item(w_bra, DM, PT, 1536, 0, scr, 64 * (r / 32), 32 * (r % 32), F.lane, RmTau()); continue; } r -= I_A;
        p0_transpose_item(w_out, DM, WOUT, 1024, 0, scr, 64 * (r / 32), 32 * (r % 32), F.lane, RmTau());
    }
}
__device__ __forceinline__ void p0b(Frame& F, const Args& a) {
    const float* x = a.in[0]; const float* b_ada = a.in[3]; const float* norm_w = a.in[4]; const float* modp = (const float*)(a.ws + WS_MODP);
    bf16* XN = (bf16*)(a.ws + WS_XN); float* modg = (float*)(a.ws + WS_MODG);
    LAS float* tg = (LAS float*)F.lds; LAS float* ts = tg + 1024;
    int curb = -1;
    for (int blk = F.vcu; blk < M / 64; blk += F.G) {
        const int b = blk / (SEQ / 64);
        if (b != curb) { __syncthreads();
            for (int k = F.tid; k < 2048; k += NWAVES * 64) { const int col = (k < 1024) ? 1024 + k : k - 1024; float s = b_ada[col];
#pragma unroll
                for (int ks = 0; ks < 8; ++ks) s += modp[(size_t)(ks * 2 + b) * 3072 + col];
                if (k < 1024) tg[k] = norm_w[k] * (1.f + s); else ts[k - 1024] = s; }
            __syncthreads(); curb = b; }
        f32x4 v[8][4];
#pragma unroll
        for (int i = 0; i < 8; ++i) { const GAS f32x4* xr = (const GAS f32x4*)(x + (size_t)(blk * 64 + F.wave * 8 + i) * DM) + F.lane;
#pragma unroll
            for (int j = 0; j < 4; ++j) v[i][j] = xr[64 * j]; }
#pragma unroll
        for (int i = 0; i < 8; ++i) { const int m = blk * 64 + F.wave * 8 + i; float ss = 0.f;
#pragma unroll
            for (int j = 0; j < 4; ++j) ss += (v[i][j][0] * v[i][j][0] + v[i][j][1] * v[i][j][1]) + (v[i][j][2] * v[i][j][2] + v[i][j][3] * v[i][j][3]);
            const float rstd = __builtin_amdgcn_rsqf(wave_sum(ss) * (1.f / DM) + EPS);
            GAS u32x2* o8 = (GAS u32x2*)(XN + (size_t)m * DM) + F.lane;
#pragma unroll
            for (int j = 0; j < 4; ++j) { const f32x4 g = *(const LAS f32x4*)(tg + 4 * F.lane + 256 * j), s = *(const LAS f32x4*)(ts + 4 * F.lane + 256 * j); const f32x4 h = v[i][j] * rstd * g + s;
                u32x2 w; w.x = cvt_pk_bf16(h[0], h[1]); w.y = cvt_pk_bf16(h[2], h[3]); o8[64 * j] = w; } }
    }
    if (F.vcu == 0) for (int k = F.tid; k < 2048; k += NWAVES * 64) { const int b = k >> 10, col = 2048 + (k & 1023); float s = b_ada[col];
#pragma unroll
        for (int ks = 0; ks < 8; ++ks) s += modp[(size_t)(ks * 2 + b) * 3072 + col];
        modg[k] = s; }
    __syncthreads();
}

__device__ __forceinline__ int rho512(int t) { return (t & ~31) | ((t ^ (t >> 5)) & 31); }
__device__ __forceinline__ void attn_tile(LAS float* Oacc, LAS float* Lacc, const bf16* Qn, const bf16* Kn, const bf16* VT, int b, int j, int T0, int ti, int lane, float shift) {
    const int g = ti >> 4, tt = ti & 15, sh = 2 * g, r32 = lane & 31, h = lane >> 5;
    int r, lq0;
    if (g == 0) { r = 0; lq0 = T0 + 32 * tt; } else if (g == 1) { r = tt >> 2; lq0 = (T0 >> 2) + 32 * (tt & 3); } else { r = tt; lq0 = T0 >> 4; }
    const int head = g * 8 + j, L = SEQ >> sh;
    const int tq = ((lq0 + r32) << sh) + r;
    const unsigned hb = ((unsigned)(b * 24 + head) << 20) + (unsigned)lane * 16u;
    const int kl0 = lq0 - 128, pos0 = r * L;
    bf16x8 qf[4], kf[5][4], v0f[5][2], v1f[5][2];
    { const char* qp = (const char*)Qn + hb + ((unsigned)((pos0 + lq0) >> 5) << 12);
#pragma unroll
      for (int s = 0; s < 4; ++s) qf[s] = *(const GAS bf16x8*)(qp + 1024 * s); }
#pragma unroll
    for (int kb = 0; kb < 5; ++kb) { const int klb = kl0 + 32 * kb, klc = klb < 0 ? 0 : klb; const char* kp = (const char*)Kn + hb + ((unsigned)((pos0 + klc) >> 5) << 12);
#pragma unroll
        for (int s = 0; s < 4; ++s) kf[kb][s] = *(const GAS bf16x8*)(kp + 1024 * s); }
#pragma unroll
    for (int kb = 0; kb < 5; ++kb) { const int klb = kl0 + 32 * kb, klc = klb < 0 ? 0 : klb; const char* vp = (const char*)VT + hb + ((unsigned)((pos0 + klc) >> 5) << 12);
        v0f[kb][0] = *(const GAS bf16x8*)(vp); v0f[kb][1] = *(const GAS bf16x8*)(vp + 1024); v1f[kb][0] = *(const GAS bf16x8*)(vp + 2048); v1f[kb][1] = *(const GAS bf16x8*)(vp + 3072); }
    u32x4 pw[5][2]; float lsum = 0.f;
#pragma unroll
    for (int kb = 0; kb < 5; ++kb) {
        f32x16 sacc = {};
#pragma unroll
        for (int s = 0; s < 4; ++s) sacc = __builtin_amdgcn_mfma_f32_32x32x16_bf16(kf[kb][s], qf[s], sacc, 0, 0, 0);
        const bool blk_ok = (kl0 + 32 * kb) >= 0;
        float p[16];
#pragma unroll
        for (int rg = 0; rg < 16; ++rg) { const int kk = (rg & 3) + 8 * (rg >> 2) + 4 * h; float e = __builtin_amdgcn_exp2f(sacc[rg] - shift);
            if (kb == 0) e = (kk >= r32) ? e : 0.f;
            if (kb == 4) e = (kk <= r32) ? e : 0.f;
            if (kb < 4) e = blk_ok ? e : 0.f;
            p[rg] = e; lsum += e; }
        pw[kb][0].x = cvt_pk_bf16(p[0], p[1]); pw[kb][0].y = cvt_pk_bf16(p[2], p[3]); pw[kb][0].z = cvt_pk_bf16(p[4], p[5]); pw[kb][0].w = cvt_pk_bf16(p[6], p[7]);
        pw[kb][1].x = cvt_pk_bf16(p[8], p[9]); pw[kb][1].y = cvt_pk_bf16(p[10], p[11]); pw[kb][1].z = cvt_pk_bf16(p[12], p[13]); pw[kb][1].w = cvt_pk_bf16(p[14], p[15]);
    }
    f32x16 o0 = {}, o1 = {};
#pragma unroll
    for (int kb = 0; kb < 5; ++kb) { o0 = __builtin_amdgcn_mfma_f32_32x32x16_bf16(v0f[kb][0], __builtin_bit_cast(bf16x8, pw[kb][0]), o0, 0, 0, 0); o0 = __builtin_amdgcn_mfma_f32_32x32x16_bf16(v0f[kb][1], __builtin_bit_cast(bf16x8, pw[kb][1]), o0, 0, 0, 0); }
#pragma unroll
    for (int kb = 0; kb < 5; ++kb) { o1 = __builtin_amdgcn_mfma_f32_32x32x16_bf16(v1f[kb][0], __builtin_bit_cast(bf16x8, pw[kb][0]), o1, 0, 0, 0); o1 = __builtin_amdgcn_mfma_f32_32x32x16_bf16(v1f[kb][1], __builtin_bit_cast(bf16x8, pw[kb][1]), o1, 0, 0, 0); }
    const int rho = rho512(tq - T0); LAS float* op = Oacc + rho * 65 + 4 * h;
    lsum += __shfl_xor(lsum, 32);
    if (g == 0) {
#pragma unroll
        for (int rg = 0; rg < 16; ++rg) { const int dd = (rg & 3) + 8 * (rg >> 2); op[dd] = o0[rg]; op[32 + dd] = o1[rg]; }
        if (h == 0) Lacc[rho] = lsum;
    } else {
        float t0[16], t1[16];
#pragma unroll
        for (int rg = 0; rg < 16; ++rg) { const int dd = (rg & 3) + 8 * (rg >> 2); t0[rg] = op[dd]; t1[rg] = op[32 + dd]; }
        const float lo = Lacc[rho];
#pragma unroll
        for (int rg = 0; rg < 16; ++rg) { const int dd = (rg & 3) + 8 * (rg >> 2); op[dd] = t0[rg] + o0[rg]; op[32 + dd] = t1[rg] + o1[rg]; }
        if (h == 0) Lacc[rho] = lo + lsum;
    }
}
__device__ __forceinline__ void conv_rows(const bf16* UB, const float* cw, bf16* YA, int row0, int tid) {
    const int c8 = tid & 127, seg = tid >> 7, ch0 = 8 * c8, rbeg = row0 + 16 * seg, t0 = rbeg & (SEQ - 1);
    const f32x4 w0a = *(const f32x4*)(cw + ch0), w0b = *(const f32x4*)(cw + ch0 + 4), w1a = *(const f32x4*)(cw + 1024 + ch0), w1b = *(const f32x4*)(cw + 1024 + ch0 + 4), w2a = *(const f32x4*)(cw + 2048 + ch0), w2b = *(const f32x4*)(cw + 2048 + ch0 + 4);
    const bf16* ub = UB + (size_t)rbeg * 2048 + 16 * c8;
    f32x4 u1a = {}, u1b = {}, u2a = {}, u2b = {}, dmy;
    if (t0 >= 2) { pg8::unpack8(*(const GAS u32x4*)(ub - 4096), u2a, dmy); pg8::unpack8(*(const GAS u32x4*)(ub - 4096 + 8), u2b, dmy);
                   pg8::unpack8(*(const GAS u32x4*)(ub - 2048), u1a, dmy); pg8::unpack8(*(const GAS u32x4*)(ub - 2048 + 8), u1b, dmy); }
#pragma unroll
    for (int half = 0; half < 2; ++half) {
        u32x4 ra[8], rb[8];
#pragma unroll
        for (int i = 0; i < 8; ++i) { ra[i] = *(const GAS u32x4*)(ub + (size_t)(8 * half + i) * 2048); rb[i] = *(const GAS u32x4*)(ub + (size_t)(8 * half + i) * 2048 + 8); }
#pragma unroll
        for (int i = 0; i < 8; ++i) { f32x4 u0a, bza, u0b, bzb; pg8::unpack8(ra[i], u0a, bza); pg8::unpack8(rb[i], u0b, bzb);
            const f32x4 ya = bza * (w0a * u2a + w1a * u1a + w2a * u0a), yb = bzb * (w0b * u2b + w1b * u1b + w2b * u0b);
            *(GAS u32x4*)(YA + (size_t)(rbeg + 8 * half + i) * DM + ch0) = pg8::pack8(ya, yb);
            u2a = u1a; u2b = u1b; u1a = u0a; u1b = u0b; }
    }
}
__device__ __forceinline__ void attn_phase(Frame& F, const Args& a) {
    const bf16* Qn = (const bf16*)(a.ws + WS_Q); const bf16* Kn = (const bf16*)(a.ws + WS_K); const bf16* VT = (const bf16*)(a.ws + WS_VT); bf16* SZ = (bf16*)(a.ws + WS_SZ);
    const bf16* UB = (const bf16*)a.out; const float* cw = a.in[6]; const float* wq = a.in[7]; const float* wk = a.in[8];
    LAS float* Oacc = (LAS float*)F.lds; LAS float* Lacc = Oacc + 512 * 65;
    for (int blk = F.vcu; blk < M / 64; blk += F.G) conv_rows(UB, cw, (bf16*)(a.ws + WS_YA), blk * 64, F.tid);
    float mw = 0.f;
    for (int d = 0; d < 64; ++d) mw = fmaxf(mw, fabsf(wq[d] * wk[d]));
    const float shift = 64.f * mw * QSCALE * 1.02f + 0.5f;
    for (int unit = F.vcu; unit < 256; unit += F.G) {
        const int b = unit >> 7, j = (unit >> 4) & 7, tb = unit & 15, T0 = tb * 512;
#pragma unroll 1
        for (int gg = 0; gg < 3; ++gg) {
            attn_tile(Oacc, Lacc, Qn, Kn, VT, b, j, T0, 16 * gg + F.wave, F.lane, shift);
            attn_tile(Oacc, Lacc, Qn, Kn, VT, b, j, T0, 16 * gg + 8 + F.wave, F.lane, shift);
            __syncthreads();
        }
        { const int c = F.tid & 7; u32x4 zz[8];
#pragma unroll
          for (int ps = 0; ps < 8; ++ps) zz[ps] = *(const GAS u32x4*)(SZ + (size_t)(b * SEQ + T0 + (F.tid >> 3) + 64 * ps) * 512 + j * 64 + 8 * c);
#pragma unroll
          for (int ps = 0; ps < 8; ++ps) { const int tok = (F.tid >> 3) + 64 * ps, rho = rho512(tok); const size_t row = (size_t)(b * SEQ + T0 + tok);
              const float il = __builtin_amdgcn_rcpf(Lacc[rho]); const LAS float* op = Oacc + rho * 65 + 8 * c;
              f32x4 z0, z1; pg8::unpack8(zz[ps], z0, z1);
              f32x4 y0, y1;
#pragma unroll
              for (int i = 0; i < 4; ++i) { y0[i] = op[i] * il * z0[i]; y1[i] = op[4 + i] * il * z1[i]; }
              if (!a.pad) *(GAS u32x4*)(SZ + row * 512 + j * 64 + 8 * c) = pg8::pack8(y0, y1); } }
        __syncthreads();
    }
}

enum { PH_P0A = 0, PH_P0B, PH_G1, PH_ATT, PH_G2, PH_G3, PH_N };
__global__ void __launch_bounds__(NWAVES * 64, 2) mk_fwd(Args args) {
    extern __shared__ __attribute__((aligned(16))) unsigned char lds_raw[];
    Frame F;
    F.lds = (LAS unsigned char*)lds_raw; F.MISC = (volatile LAS unsigned*)(F.lds + MISC_OFF);
    F.tid = threadIdx.x; F.lane = F.tid & 63; F.wave = __builtin_amdgcn_readfirstlane(F.tid >> 6);
    F.G = gridDim.x; { const int bx = blockIdx.x; F.vcu = (F.G % 8 == 0) ? (bx % 8) * (F.G / 8) + bx / 8 : bx; }
    F.ctl = (gu32*)(args.ws + WS_CTL);
    for (int u = F.tid; u < (LDS_BYTES - LDSCTL_OFF) / 4; u += NWAVES * 64) ((LAS unsigned*)(F.lds + LDSCTL_OFF))[u] = 0u;
    __syncthreads();
    const int lo = args.ph_lo, hi = args.ph_hi;
    XcdBarrier bar; bar.bar = (unsigned*)(F.ctl + CW_BAR) + args.li * XCD_BAR_WORDS; bar.x = 0; bar.st = nullptr;
    if (hi - lo > 1) bar = xcd_barrier_post((unsigned*)(F.ctl + CW_BAR) + args.li * XCD_BAR_WORDS, F.MISC + 8);
#define IN(k) (lo <= (k) && (k) < hi)
#define SEAM(k) do { if (IN(k) && IN((k) + 1)) xcd_barrier(bar); } while (0)
    unsigned char* ws = args.ws;
#ifdef TS_A
    unsigned long long ts0 = __builtin_amdgcn_s_memrealtime(), ts1 = 0, ts2 = 0, ts3 = 0, ts4 = 0, ts5 = 0, ts6 = 0;
#define TS(k) ts##k = __builtin_amdgcn_s_memrealtime()
#else
#define TS(k)
#endif
#ifndef NO_P0
    if (IN(PH_P0A)) { p0a(F, args); SEAM(PH_P0A); } TS(1);
    if (IN(PH_P0B)) { p0b(F, args); SEAM(PH_P0B); } TS(2);
#endif
#ifndef NO_G1
    if (IN(PH_G1)) {
        pg8::SchedG1 S{(const char*)(ws + WS_XN), (const char*)(ws + WS_WALL), F.G, (int)blockIdx.x};
        pg8::EpiG1 E{mk_rsrc(args.out, 64u << 20), mk_rsrc(ws + WS_Q, 48u << 20), mk_rsrc(ws + WS_K, 48u << 20), mk_rsrc(ws + WS_VT, 48u << 20), mk_rsrc(ws + WS_SZ, 16u << 20), mk_rsrc(ws + WS_G8, 32u << 20), args.in[7], args.in[8]};
        pg8::gemm_phase(F.lds, S, E, args.pad); SEAM(PH_G1);
    }
    TS(3);
#endif
#ifndef NO_ATT
    if (IN(PH_ATT)) { attn_phase(F, args); SEAM(PH_ATT); } TS(4);
#endif
#ifndef NO_G2
    if (IN(PH_G2)) {
        pg8::SchedG2 S{(const char*)(ws + WS_SZ), (const char*)(ws + WS_YA), (const char*)(ws + WS_PT), F.G, (int)blockIdx.x};
        pg8::EpiG2 E{ws + WS_G8, (bf16*)(ws + WS_T), mk_rsrc(ws + WS_MG2, 32u << 20)};
        pg8::gemm_phase(F.lds, S, E); SEAM(PH_G2);
    }
    TS(5);
#endif
#ifndef NO_G3
    if (IN(PH_G3)) {
        pg8::SchedG3 S{(const char*)(ws + WS_MG2), (const char*)(ws + WS_WOUT), F.G, (int)blockIdx.x};
        pg8::EpiG3 E{args.in[0], args.out, (const float*)(ws + WS_MODG)};
        pg8::gemm_phase(F.lds, S, E);
#ifdef TS_A
        TS(6);
        if (blockIdx.x == 0 && F.tid == 0) { pg8::UnitD u0; S.next(0, u0); const unsigned long long tt[7] = {ts0, ts1, ts2, ts3, ts4, ts5, ts6};
            const float us = (float)(tt[TS_B] - tt[TS_A]) * 0.01f; asm volatile("s_waitcnt vmcnt(0)" ::: "memory");
            args.out[(size_t)(u0.pm * 256) * DM + u0.pn * 256] += us / (float)TS_DIV; }
#endif
    }
#endif
#undef IN
#undef SEAM
}
static int g_grid = 0;
extern "C" void kernel_launch(void* const* d_in, const int* in_sizes, int n_in, void* d_out, int out_size, void* d_ws, size_t ws_size, hipStream_t stream) {
    if (g_grid == 0) {
        int dev = 0, cus = 0;
        (void)hipGetDevice(&dev); (void)hipDeviceGetAttribute(&cus, hipDeviceAttributeMultiprocessorCount, dev);
        (void)hipFuncSetAttribute((const void*)mk_fwd, hipFuncAttributeMaxDynamicSharedMemorySize, LDS_BYTES);
        (void)hipGetLastError();
        g_grid = cus > 0 ? cus : 256;
    }
    unsigned char* ws = (unsigned char*)d_ws;
    (void)hipMemsetAsync(ws + WS_CTL, 0, 64 * 1024, stream);
#ifdef EXTRA_MEMSET
    (void)hipMemsetAsync(ws + WS_CTL + 128 * 1024, 0, 64 * 1024, stream);
#endif
    Args a{}; for (int i = 0; i < 12; ++i) a.in[i] = (const float*)d_in[i]; a.out = (float*)d_out; a.ws = ws; a.ph_lo = 0; a.ph_hi = PH_N; a.li = 0; a.pad = 0;
#ifdef PHASE_LIST
    { const int pl[] = PHASE_LIST; for (int ph : pl) { a.pad = ph / 100; a.ph_lo = ph % 100; a.ph_hi = ph % 100 + 1; hipLaunchKernelGGL(mk_fwd, dim3(g_grid), dim3(NWAVES * 64), LDS_BYTES, stream, a); } }
#else
    hipLaunchKernelGGL(mk_fwd, dim3(g_grid), dim3(NWAVES * 64), LDS_BYTES, stream, a);
#endif
}
```
